# Optimizing an MI355X kernel written in HIP

```python
import math
import jax, jax.numpy as jnp
from jax import lax
import numpy as np

D_MODEL = 1024
BATCH = 8
SEQ = 2048
DEPTH = 1
DEC_BATCH = 16
DEC_SEQ = 32
PAST_LEN = 1024

CHUNK = 64
Q_BLOCK = 128
SSD_HEADS = 16
SSD_HEAD_DIM = 64
SSD_D_INNER = SSD_HEADS * SSD_HEAD_DIM
SSD_GROUPS = 2
SSD_HEADS_PER_GROUP = SSD_HEADS // SSD_GROUPS
SSD_STATE = 128
CONV_W = 4
SSD_CONV_DIM = SSD_D_INNER + 2 * SSD_GROUPS * SSD_STATE
MLA_HEADS = 8
Q_LORA = 512
KV_LORA = 512
QK_NOPE = 128
QK_ROPE = 64
V_HEAD = 128
MLA_WIDTH = MLA_HEADS * V_HEAD
ROPE_THETA = 10000.0
D_MIX = SSD_D_INNER + MLA_WIDTH
D_IN_PROJ = SSD_D_INNER + SSD_CONV_DIM + SSD_HEADS + Q_LORA + KV_LORA + QK_ROPE
D_FF = 2816
ALPHA = (2 * DEPTH) ** 0.25
BETA = (8 * DEPTH) ** -0.25
EPS = 1e-5

kernel_name = "hybrid_ssd_mla_streaming_step"


def layer_norm(x, g, b):
    xf = x.astype(jnp.float32)
    mu = jnp.mean(xf, -1, keepdims=True)
    var = jnp.mean(jnp.square(xf - mu), -1, keepdims=True)
    return ((xf - mu) * lax.rsqrt(var + EPS) * g + b).astype(x.dtype)


def rms_norm(x, g):
    xf = x.astype(jnp.float32)
    return (xf * lax.rsqrt(jnp.mean(jnp.square(xf), -1, keepdims=True) + EPS) * g).astype(x.dtype)


def swiglu(x, w_gate, w_up, w_down):
    return (jax.nn.silu(x @ w_gate) * (x @ w_up)) @ w_down


def rope_cos_sin(pos):
    inv = ROPE_THETA ** (-jnp.arange(0, QK_ROPE, 2, dtype=jnp.float32) / QK_ROPE)
    ang = pos.astype(jnp.float32)[:, None] * inv[None, :]
    return jnp.cos(ang), jnp.sin(ang)


def rotate(x, cos, sin):
    x1, x2 = jnp.split(x.astype(jnp.float32), 2, axis=-1)
    return jnp.concatenate([x1 * cos - x2 * sin, x1 * sin + x2 * cos], -1).astype(x.dtype)


def causal_conv(xpad, w, b):
    L = xpad.shape[1] - (CONV_W - 1)
    out = b
    for k in range(CONV_W):
        out = out + xpad[:, k:k + L] * w[k]
    return out


def ssd_scan(xdt, dA, Bm, Cm, h0, chunk):
    b, L, H, P = xdt.shape
    G, Hg, N = SSD_GROUPS, SSD_HEADS_PER_GROUP, SSD_STATE
    nc = L // chunk
    dt_ = xdt.dtype
    x = xdt.reshape(b, nc, chunk, G, Hg, P)
    Bc = Bm.reshape(b, nc, chunk, G, N)
    Cc = Cm.reshape(b, nc, chunk, G, N)
    a_cs = jnp.cumsum(dA.reshape(b, nc, chunk, H), axis=2)
    seg = a_cs[:, :, :, None, :] - a_cs[:, :, None, :, :]
    tri = jnp.tril(jnp.ones((chunk, chunk), bool))[None, None, :, :, None]
    Lm = jnp.exp(jnp.where(tri, seg, -jnp.inf)).astype(dt_).reshape(b, nc, chunk, chunk, G, Hg)
    cb = jnp.einsum('bcign,bcjgn->bcijg', Cc, Bc)
    y_diag = jnp.einsum('bcijg,bcijgh,bcjghp->bcighp', cb, Lm, x)
    decay_states = jnp.exp(a_cs[:, :, -1:, :] - a_cs).astype(dt_).reshape(b, nc, chunk, G, Hg)
    states = jnp.einsum('bcjgn,bcjgh,bcjghp->bcghpn', Bc, decay_states, x)
    chunk_decay = jnp.exp(a_cs[:, :, -1, :]).astype(dt_).reshape(b, nc, G, Hg)

    def step(h, inp):
        dec, st = inp
        return dec[..., None, None] * h + st, h

    h_init = h0.astype(states.dtype).reshape(b, G, Hg, P, N)
    h_final, h_prev = lax.scan(step, h_init, (jnp.moveaxis(chunk_decay, 1, 0), jnp.moveaxis(states, 1, 0)))
    h_prev = jnp.moveaxis(h_prev, 0, 1)
    in_decay = jnp.exp(a_cs).astype(dt_).reshape(b, nc, chunk, G, Hg)
    y_off = jnp.einsum('bcign,bcigh,bcghpn->bcighp', Cc, in_decay, h_prev)
    y = (y_diag + y_off).reshape(b, L, H, P)
    return y, h_final.reshape(b, H, P, N)


def mla_attend(q_nope, q_rope, k_nope, k_rope, v, q_pos, k_pos):
    s = jnp.einsum('bqhd,bkhd->bhqk', q_nope, k_nope) + jnp.einsum('bqhd,bkd->bhqk', q_rope, k_rope)
    s = s.astype(jnp.float32) * ((QK_NOPE + QK_ROPE) ** -0.5)
    mask = (k_pos // CHUNK)[None, :] <= (q_pos // CHUNK)[:, None]
    s = jnp.where(mask, s, -1e30)
    p = jax.nn.softmax(s, axis=-1).astype(v.dtype)
    return jnp.einsum('bhqk,bkhd->bqhd', p, v)


def token_mix(h, conv_prev, h0, lat_prev, kr_prev, pos0,
              w_in, conv_w, conv_b, dt_bias, a_log, d_skip, ssd_norm_g,
              q_norm_g, w_uq, kv_norm_g, w_ukv, w_out):
    b, L, _ = h.shape
    proj = h @ w_in
    idx = [SSD_D_INNER, SSD_D_INNER + SSD_CONV_DIM, SSD_D_INNER + SSD_CONV_DIM + SSD_HEADS,
           SSD_D_INNER + SSD_CONV_DIM + SSD_HEADS + Q_LORA,
           SSD_D_INNER + SSD_CONV_DIM + SSD_HEADS + Q_LORA + KV_LORA]
    z, xbc, dt_raw, c_q, c_kv, k_r = jnp.split(proj, idx, axis=-1)

    xpad = jnp.concatenate([conv_prev.astype(xbc.dtype), xbc], axis=1)
    new_conv = xpad[:, -(CONV_W - 1):]
    xbc_c = jax.nn.silu(causal_conv(xpad, conv_w, conv_b))
    xs, Bm, Cm = jnp.split(xbc_c, [SSD_D_INNER, SSD_D_INNER + SSD_GROUPS * SSD_STATE], axis=-1)
    xs = xs.reshape(b, L, SSD_HEADS, SSD_HEAD_DIM)
    Bm = Bm.reshape(b, L, SSD_GROUPS, SSD_STATE)
    Cm = Cm.reshape(b, L, SSD_GROUPS, SSD_STATE)
    dt = jax.nn.softplus(dt_raw.astype(jnp.float32) + dt_bias)
    A = -jnp.exp(a_log.astype(jnp.float32))
    chunk = min(CHUNK, L)
    y, h_new = ssd_scan(xs * dt[..., None].astype(xs.dtype), dt * A, Bm, Cm, h0, chunk)
    y = y + d_skip[:, None] * xs
    y = y.reshape(b, L, SSD_D_INNER) * jax.nn.silu(z)
    y = rms_norm(y.reshape(b, L, SSD_GROUPS, SSD_D_INNER // SSD_GROUPS),
                 ssd_norm_g.reshape(SSD_GROUPS, SSD_D_INNER // SSD_GROUPS)).reshape(b, L, SSD_D_INNER)

    q_pos = pos0 + jnp.arange(L)
    k_pos = jnp.arange(pos0 + L)
    cos_q, sin_q = rope_cos_sin(q_pos)
    q = (rms_norm(c_q, q_norm_g) @ w_uq).reshape(b, L, MLA_HEADS, QK_NOPE + QK_ROPE)
    q_nope, q_rope = q[..., :QK_NOPE], rotate(q[..., QK_NOPE:], cos_q[:, None, :], sin_q[:, None, :])
    lat_new = rms_norm(c_kv, kv_norm_g)
    kr_new = rotate(k_r, cos_q, sin_q)
    all_lat = jnp.concatenate([lat_prev.astype(lat_new.dtype), lat_new], axis=1)
    all_kr = jnp.concatenate([kr_prev.astype(kr_new.dtype), kr_new], axis=1)
    K = all_lat.shape[1]
    kv = (all_lat @ w_ukv).reshape(b, K, MLA_HEADS, QK_NOPE + V_HEAD)
    k_nope, v = kv[..., :QK_NOPE], kv[..., QK_NOPE:]
    if L > Q_BLOCK and L % Q_BLOCK == 0:
        nb = L // Q_BLOCK
        qn_b = q_nope.reshape(b, nb, Q_BLOCK, MLA_HEADS, QK_NOPE).swapaxes(0, 1)
        qr_b = q_rope.reshape(b, nb, Q_BLOCK, MLA_HEADS, QK_ROPE).swapaxes(0, 1)
        qp_b = q_pos.reshape(nb, Q_BLOCK)
        o = lax.map(lambda a: mla_attend(a[0], a[1], k_nope, all_kr, v, a[2], k_pos), (qn_b, qr_b, qp_b))
        o = o.swapaxes(0, 1).reshape(b, L, MLA_WIDTH)
    else:
        o = mla_attend(q_nope, q_rope, k_nope, all_kr, v, q_pos, k_pos).reshape(b, L, MLA_WIDTH)

    out = jnp.concatenate([y, o], axis=-1) @ w_out
    return out, new_conv, h_new, lat_new, kr_new


def layer(x, conv_prev, h0, lat_prev, kr_prev, pos0,
          ln1_g, ln1_b, ffn1_w_gate, ffn1_w_up, ffn1_w_down,
          w_in, conv_w, conv_b, dt_bias, a_log, d_skip, ssd_norm_g,
          q_norm_g, w_uq, kv_norm_g, w_ukv, w_out, ln2_g, ln2_b,
          ffn2_w_gate, ffn2_w_up, ffn2_w_down, ln3_g, ln3_b):
    x = layer_norm(ALPHA * x + 0.5 * swiglu(x, ffn1_w_gate, ffn1_w_up, ffn1_w_down), ln1_g, ln1_b)
    mix, new_conv, h_new, lat_new, kr_new = token_mix(
        x, conv_prev, h0, lat_prev, kr_prev, pos0, w_in, conv_w, conv_b, dt_bias, a_log, d_skip,
        ssd_norm_g, q_norm_g, w_uq, kv_norm_g, w_ukv, w_out)
    x = layer_norm(ALPHA * x + mix, ln2_g, ln2_b)
    x = layer_norm(ALPHA * x + 0.5 * swiglu(x, ffn2_w_gate, ffn2_w_up, ffn2_w_down), ln3_g, ln3_b)
    return x, new_conv, h_new, lat_new, kr_new


def setup_inputs(seed: int = 0) -> dict:
    key = jax.random.key(seed)
    ks = jax.random.split(key, 40)
    f32 = jnp.float32

    def nrm(k, shape, scale):
        return jax.random.normal(k, shape, f32) * scale

    def gain(k, shape):
        return 1.0 + 0.02 * jax.random.normal(k, shape, f32)

    dt0 = jnp.exp(jax.random.uniform(ks[20], (DEPTH, SSD_HEADS), f32, math.log(1e-3), math.log(1e-1)))
    return {
        "x_prompt": nrm(ks[0], (BATCH, SEQ, D_MODEL), 1.0),
        "x_sample": nrm(ks[1], (DEC_BATCH, DEC_SEQ, D_MODEL), 1.0),
        "cache_latent": nrm(ks[2], (DEPTH, DEC_BATCH, PAST_LEN, KV_LORA), 1.0),
        "cache_k_rope": nrm(ks[3], (DEPTH, DEC_BATCH, PAST_LEN, QK_ROPE), 1.0),
        "state_conv": nrm(ks[4], (DEPTH, DEC_BATCH, CONV_W - 1, SSD_CONV_DIM), 1.0),
        "state_ssm": nrm(ks[5], (DEPTH, DEC_BATCH, SSD_HEADS, SSD_HEAD_DIM, SSD_STATE), 0.1),
        "ln1_g": gain(ks[6], (DEPTH, D_MODEL)),
        "ln1_b": nrm(ks[7], (DEPTH, D_MODEL), 0.02),
        "ffn1_w_gate": nrm(ks[8], (DEPTH, D_MODEL, D_FF), D_MODEL ** -0.5),
        "ffn1_w_up": nrm(ks[9], (DEPTH, D_MODEL, D_FF), D_MODEL ** -0.5),
        "ffn1_w_down": nrm(ks[10], (DEPTH, D_FF, D_MODEL), BETA * D_FF ** -0.5),
        "w_in": nrm(ks[11], (DEPTH, D_MODEL, D_IN_PROJ), D_MODEL ** -0.5),
        "conv_w": nrm(ks[12], (DEPTH, CONV_W, SSD_CONV_DIM), CONV_W ** -0.5),
        "conv_b": nrm(ks[13], (DEPTH, SSD_CONV_DIM), 0.02),
        "dt_bias": dt0 + jnp.log(-jnp.expm1(-dt0)),
        "a_log": jnp.log(jax.random.uniform(ks[14], (DEPTH, SSD_HEADS), f32, 1.0, 16.0)),
        "d_skip": gain(ks[15], (DEPTH, SSD_HEADS)),
        "ssd_norm_g": gain(ks[16], (DEPTH, SSD_D_INNER)),
        "q_norm_g": gain(ks[17], (DEPTH, Q_LORA)),
        "w_uq": nrm(ks[18], (DEPTH, Q_LORA, MLA_HEADS * (QK_NOPE + QK_ROPE)), Q_LORA ** -0.5),
        "kv_norm_g": gain(ks[19], (DEPTH, KV_LORA)),
        "w_ukv": nrm(ks[21], (DEPTH, KV_LORA, MLA_HEADS * (QK_NOPE + V_HEAD)), KV_LORA ** -0.5),
        "w_out": nrm(ks[22], (DEPTH, D_MIX, D_MODEL), BETA * D_MIX ** -0.5),
        "ln2_g": gain(ks[23], (DEPTH, D_MODEL)),
        "ln2_b": nrm(ks[24], (DEPTH, D_MODEL), 0.02),
        "ffn2_w_gate": nrm(ks[25], (DEPTH, D_MODEL, D_FF), D_MODEL ** -0.5),
        "ffn2_w_up": nrm(ks[26], (DEPTH, D_MODEL, D_FF), D_MODEL ** -0.5),
        "ffn2_w_down": nrm(ks[27], (DEPTH, D_FF, D_MODEL), BETA * D_FF ** -0.5),
        "ln3_g": gain(ks[28], (DEPTH, D_MODEL)),
        "ln3_b": nrm(ks[29], (DEPTH, D_MODEL), 0.02),
    }


def reference(x_prompt, x_sample, cache_latent, cache_k_rope, state_conv, state_ssm,
              ln1_g, ln1_b, ffn1_w_gate, ffn1_w_up, ffn1_w_down,
              w_in, conv_w, conv_b, dt_bias, a_log, d_skip, ssd_norm_g,
              q_norm_g, w_uq, kv_norm_g, w_ukv, w_out, ln2_g, ln2_b,
              ffn2_w_gate, ffn2_w_up, ffn2_w_down, ln3_g, ln3_b):
    xp, xs = x_prompt, x_sample
    bp = xp.shape[0]
    lat_p, kr_p, conv_p, ssm_p = [], [], [], []
    lat_s, kr_s, conv_s, ssm_s = [], [], [], []
    for l in range(DEPTH):
        lw = (ln1_g[l], ln1_b[l], ffn1_w_gate[l], ffn1_w_up[l], ffn1_w_down[l],
              w_in[l], conv_w[l], conv_b[l], dt_bias[l], a_log[l], d_skip[l], ssd_norm_g[l],
              q_norm_g[l], w_uq[l], kv_norm_g[l], w_ukv[l], w_out[l], ln2_g[l], ln2_b[l],
              ffn2_w_gate[l], ffn2_w_up[l], ffn2_w_down[l], ln3_g[l], ln3_b[l])
        xp, c1, h1, la1, kr1 = layer(
            xp, jnp.zeros((bp, CONV_W - 1, SSD_CONV_DIM), xp.dtype),
            jnp.zeros((bp, SSD_HEADS, SSD_HEAD_DIM, SSD_STATE), xp.dtype),
            jnp.zeros((bp, 0, KV_LORA), xp.dtype), jnp.zeros((bp, 0, QK_ROPE), xp.dtype), 0, *lw)
        xs, c2, h2, la2, kr2 = layer(
            xs, state_conv[l], state_ssm[l], cache_latent[l], cache_k_rope[l], PAST_LEN, *lw)
        lat_p.append(la1); kr_p.append(kr1); conv_p.append(c1); ssm_p.append(h1)
        lat_s.append(la2); kr_s.append(kr2); conv_s.append(c2); ssm_s.append(h2)
    return (xp, xs,
            jnp.stack(lat_p), jnp.stack(kr_p), jnp.stack(conv_p), jnp.stack(ssm_p),
            jnp.stack(lat_s), jnp.stack(kr_s), jnp.stack(conv_s), jnp.stack(ssm_s))
```

```cpp
#include <hip/hip_runtime.h>
#include <hip/hip_cooperative_groups.h>
#include <cstdio>
#include <cstdint>
#include <cmath>
namespace cg = cooperative_groups;

#define LAS __attribute__((address_space(3)))
typedef unsigned short bf16_t;
typedef short bf16x8 __attribute__((ext_vector_type(8)));
typedef float f32x4 __attribute__((ext_vector_type(4)));
typedef float f32x8 __attribute__((ext_vector_type(8)));
typedef float f32x16 __attribute__((ext_vector_type(16)));
typedef unsigned u32x4 __attribute__((ext_vector_type(4)));
typedef unsigned u32x2 __attribute__((ext_vector_type(2)));
typedef float f32x2_t __attribute__((ext_vector_type(2)));
typedef __bf16 bf16x2_t __attribute__((ext_vector_type(2)));

#define DI __device__ __forceinline__
DI unsigned cvtpk(float lo, float hi) { f32x2_t v = {lo, hi}; bf16x2_t b = __builtin_convertvector(v, bf16x2_t); return __builtin_bit_cast(unsigned, b); }
DI float bflo(unsigned w) { return __uint_as_float(w << 16); }
DI float bfhi(unsigned w) { return __uint_as_float(w & 0xffff0000u); }
DI float bf2f(bf16_t b) { return __uint_as_float((unsigned)b << 16); }
DI f32x8 unpack8(u32x4 w) { f32x8 f; f[0] = bflo(w.x); f[1] = bfhi(w.x); f[2] = bflo(w.y); f[3] = bfhi(w.y); f[4] = bflo(w.z); f[5] = bfhi(w.z); f[6] = bflo(w.w); f[7] = bfhi(w.w); return f; }
DI u32x4 pack8(f32x8 f) { u32x4 w; w.x = cvtpk(f[0], f[1]); w.y = cvtpk(f[2], f[3]); w.z = cvtpk(f[4], f[5]); w.w = cvtpk(f[6], f[7]); return w; }
DI float fast_exp(float x) { return __builtin_amdgcn_exp2f(x * 1.4426950408889634f); }
DI float silu_f(float x) { return x * __builtin_amdgcn_rcpf(1.0f + fast_exp(-x)); }
DI float wave_sum(float v) {
#pragma unroll
    for (int o = 1; o < 64; o <<= 1) v += __shfl_xor(v, o);
    return v;
}
DI int crow(int r, int hi) { return (r & 3) + 8 * (r >> 2) + 4 * hi; }
#define MFMA32(a, b, c) __builtin_amdgcn_mfma_f32_32x32x16_bf16((a), (b), (c), 0, 0, 0)

constexpr int DM = 1024, TP = 16384, TS = 512, T = TP + TS;
constexpr int DFF = 2816, NIN = 3840;
constexpr int TKS = 16896;
constexpr float ALPHA = 1.189207115002721f, EPS = 1e-5f;
constexpr size_t O_Y = 0, O_LATP = 17301504, O_KRP = 25690112, O_CONVP = 26738688, O_SSMP = 26775552,
                 O_LATS = 27824128, O_KRS = 28086272, O_CONVS = 28119040, O_SSMS = 28192768;
constexpr size_t MiB = 1u << 20;
constexpr size_t WS_ROPE = 1 * MiB;
constexpr size_t WS_WGU1 = 2 * MiB, WS_WD1 = 13 * MiB, WS_WIN = 13 * MiB + 5767168, WS_WUQ = 26 * MiB, WS_WUK = 27 * MiB + 524288,
                 WS_WUV = 28 * MiB + 524288, WS_WOUT = 29 * MiB + 524288, WS_WGU2 = 33 * MiB + 524288, WS_WD2 = 44 * MiB + 524288;
constexpr size_t WS_HB = 50 * MiB;
constexpr size_t WS_A = 83 * MiB;
constexpr size_t WS_LATS = 2 * MiB, WS_KRS = 18 * MiB + 524288;
constexpr size_t A_ACT = WS_A, A_Z = WS_A, A_MISC = WS_A + 33 * MiB, A_BC = WS_A + 74 * MiB + 262144, A_DT = WS_A + 90 * MiB + 786432,
                 A_XBC = WS_A + 92 * MiB, A_ST = WS_A + 92 * MiB, A_DEC = WS_A + 160 * MiB,
                 A_KN = WS_A, A_Q = WS_A + 74 * MiB + 262144, A_VT = WS_A + 123 * MiB + 786432,
                 A_R2 = WS_A, A_ACT2 = WS_A + 66 * MiB, A_PART = WS_A + 100 * MiB, A_PART2 = WS_A, A_KNN = WS_A + 157 * MiB, A_VTN = WS_A + 158 * MiB;
constexpr int LDS_BYTES = 147456;

namespace pg8 {
constexpr int BM = 256, BK = 64, HALF = 128, HTB = HALF * BK * 2, STAGE_BYTES = 8 * HTB, NXCD = 8, WGM = 8;
__host__ __device__ __forceinline__ int lds_byte(int r, int c) { const int st = (r >> 4) * 2 + (c >> 5), rr = r & 15, cc = c & 31, ob = rr * 64 + cc * 2; return st * 1024 + (ob ^ (((ob >> 9) & 1) << 5)); }
__host__ __device__ __forceinline__ void stage_rc(int b, int& R, int& C) { const int st = b / 1024, sb = b % 1024, swz = sb ^ (((sb >> 9) & 1) << 5); R = (st >> 1) * 16 + swz / 64; C = (st & 1) * 32 + (swz % 64) / 2; }
__host__ __device__ __forceinline__ int perm32(int rho) { const int n = rho >> 4, i = rho & 15; return 8 * (i >> 2) + 4 * n + (i & 3); }
struct Unit { int pm, pn, k0, nt, ks; };
struct Gemm { const bf16_t* A; const bf16_t* Bt; int lda, ldb, M, N, K; };
struct StaticOrder {
    int nM, nN, nwg, G, c, ntf;
    __host__ __device__ void init(int M, int N, int K, int G_, int c_) { nM = M / BM; nN = N / BM; nwg = nM * nN; G = G_; c = c_; ntf = K / BK; }
    __host__ __device__ bool next(int i, Unit& u) const {
        const long L = (long)i * G + c; if (L >= nwg) return false;
        u.k0 = 0; u.nt = ntf; u.ks = -1;
        int wgid = (int)L; { const int q = nwg / NXCD, r = nwg % NXCD, xcd = wgid % NXCD, off = wgid / NXCD; wgid = (xcd < r ? xcd * (q + 1) : r * (q + 1) + (xcd - r) * q) + off; }
        const int nig = WGM * nN, gid = wgid / nig, fm = gid * WGM, gsz = (nM - fm) < WGM ? (nM - fm) : WGM;
        u.pm = fm + ((wgid % nig) % gsz); u.pn = (wgid % nig) / gsz; return true;
    }
};
struct SplitOrder {
    StaticOrder so; int S, G, c;
    __host__ __device__ void init(int K, int S_, int G_, int c_) { so.init(TP, 1024, K, G_, c_); S = S_; G = G_; c = c_; }
    __host__ __device__ bool next(int i, Unit& u) const {
        const int Li = i * G + c, idx = Li - 256;
        const bool isP = Li < 256;
        if (!isP && idx >= 8 * S) return false;
        int wgid = isP ? Li : 0; { const int xcd = wgid % NXCD, off = wgid / NXCD; wgid = xcd * (256 / NXCD) + off; }
        const int nig = WGM * 4, gid = wgid / nig, fm = gid * WGM;
        const int pm_p = fm + ((wgid % nig) % WGM), pn_p = (wgid % nig) / WGM;
        const int ii = isP ? 0 : idx, ks_s = ii % S, rem = ii / S, nts = so.ntf / S;
        u.pm = isP ? pm_p : 64 + (rem >> 2); u.pn = isP ? pn_p : (rem & 3);
        u.k0 = isP ? 0 : ks_s * nts; u.nt = isP ? so.ntf : nts; u.ks = isP ? -1 : ks_s;
        return true;
    }
};

struct EpiStore {
    static constexpr bool PERM = true;
    bf16_t* O0; int ld0; int t1; bf16_t* O1; int ld1; int t2; bf16_t* O2; int ld2;
    DI void operator()(const f32x4 (&acc)[2][2][4][2], const Unit& u, int wr, int wc, int fr, int fq) const {
        bf16_t* base; int ld, colt;
        if (u.pn < t1) { base = O0; ld = ld0; colt = u.pn * BM; } else if (u.pn < t2) { base = O1; ld = ld1; colt = (u.pn - t1) * BM; } else { base = O2; ld = ld2; colt = (u.pn - t2) * BM; }
        const int row0 = u.pm * BM + wr * 64 + fr, col0 = colt + wc * 32 + 8 * fq;
#pragma unroll
        for (int ai = 0; ai < 2; ++ai)
#pragma unroll
            for (int m = 0; m < 4; ++m) { bf16_t* rowp = base + (size_t)(row0 + ai * HALF + m * 16) * ld + col0;
#pragma unroll
                for (int bj = 0; bj < 2; ++bj) { const f32x4 v0 = acc[ai][bj][m][0], v1 = acc[ai][bj][m][1];
                    u32x4 w; w.x = cvtpk(v0[0], v0[1]); w.y = cvtpk(v0[2], v0[3]); w.z = cvtpk(v1[0], v1[1]); w.w = cvtpk(v1[2], v1[3]);
                    *(u32x4*)(rowp + bj * HALF) = w; } }
    }
};
struct EpiSwiGLU {
    static constexpr bool PERM = true;
    bf16_t* O; int ldc;
    DI void operator()(const f32x4 (&acc)[2][2][4][2], const Unit& u, int wr, int wc, int fr, int fq) const {
        const int row0 = u.pm * BM + wr * 64 + fr, col0 = u.pn * HALF + wc * 32 + 8 * fq;
#pragma unroll
        for (int ai = 0; ai < 2; ++ai)
#pragma unroll
            for (int m = 0; m < 4; ++m) {
                const f32x4 g0 = acc[ai][0][m][0], g1 = acc[ai][0][m][1], u0 = acc[ai][1][m][0], u1 = acc[ai][1][m][1];
                u32x4 w;
                w.x = cvtpk(silu_f(g0[0]) * u0[0], silu_f(g0[1]) * u0[1]); w.y = cvtpk(silu_f(g0[2]) * u0[2], silu_f(g0[3]) * u0[3]);
                w.z = cvtpk(silu_f(g1[0]) * u1[0], silu_f(g1[1]) * u1[1]); w.w = cvtpk(silu_f(g1[2]) * u1[2], silu_f(g1[3]) * u1[3]);
                *(u32x4*)(O + (size_t)(row0 + ai * HALF + m * 16) * ldc + col0) = w;
            }
    }
};
template <bool RESF32> struct EpiRes {
    static constexpr bool PERM = false;
    float* out; const float* xp; const float* xs; const bf16_t* hb; float alpha, s; float* part;
    DI void operator()(const f32x4 (&acc)[2][2][4][2], const Unit& u, int wr, int wc, int fr, int fq) const {
        const int col0 = u.pn * BM + wc * 32 + 4 * fq;
        float alpha = this->alpha, s = this->s; float* part = this->part; float* out = this->out;
        asm volatile("" : "+s"(alpha), "+s"(s), "+s"(part), "+s"(out));
        if (u.ks >= 0) {
            float* pb = part + (size_t)u.ks * (TS * DM);
#pragma unroll
            for (int ai = 0; ai < 2; ++ai)
#pragma unroll
                for (int m = 0; m < 4; ++m) {
                    const int row = (u.pm - 64) * BM + ai * HALF + wr * 64 + m * 16 + fr;
#pragma unroll
                    for (int bj = 0; bj < 2; ++bj)
#pragma unroll
                        for (int n = 0; n < 2; ++n) *(f32x4*)(pb + (size_t)row * DM + col0 + bj * HALF + n * 16) = acc[ai][bj][m][n];
                }
        } else {
#pragma unroll
        for (int ai = 0; ai < 2; ++ai)
#pragma unroll
            for (int mh = 0; mh < 2; ++mh) {
                f32x4 r[2][2][2];
#pragma unroll
                for (int mm = 0; mm < 2; ++mm) {
                    const int row = u.pm * BM + ai * HALF + wr * 64 + (2 * mh + mm) * 16 + fr;
#pragma unroll
                    for (int bj = 0; bj < 2; ++bj)
#pragma unroll
                        for (int n = 0; n < 2; ++n) {
                            const int col = col0 + bj * HALF + n * 16;
                            if (RESF32) { const float* xr = row < TP ? xp + (size_t)row * DM : xs + (size_t)(row - TP) * DM; r[mm][bj][n] = *(const f32x4*)(xr + col); }
                            else { const u32x2 w = *(const u32x2*)(hb + (size_t)row * DM + col); r[mm][bj][n] = (f32x4){bflo(w.x), bfhi(w.x), bflo(w.y), bfhi(w.y)}; }
                        }
                }
#pragma unroll
                for (int mm = 0; mm < 2; ++mm) {
                    const int m = 2 * mh + mm, row = u.pm * BM + ai * HALF + wr * 64 + m * 16 + fr;
#pragma unroll
                    for (int bj = 0; bj < 2; ++bj)
#pragma unroll
                        for (int n = 0; n < 2; ++n) {
                            const int col = col0 + bj * HALF + n * 16;
                            const f32x4 o = r[mm][bj][n] * alpha + acc[ai][bj][m][n] * s;
                            *(f32x4*)(out + (size_t)row * DM + col) = o;
                        }
                }
            }
        }
    }
};

template <class Epi, class Sched>
DI void gemm_phase(LAS unsigned char* lds, const Gemm g, const Sched& S, const Epi& E) {
    const int tid = threadIdx.x, wid = __builtin_amdgcn_readfirstlane(tid >> 6), lane = tid & 63, wr = wid >> 2, wc = wid & 3, fr = lane & 15, fq = lane >> 4;
    unsigned voffA[2], voffB[2];
#pragma unroll
    for (int i = 0; i < 2; ++i) { int R, C; stage_rc(tid * 16 + i * 8192, R, C); const int Rb = Epi::PERM ? ((R & ~31) + perm32(R & 31)) : R;
        voffA[i] = (unsigned)(R * g.lda + C) * 2u; voffB[i] = (unsigned)(Rb * g.ldb + C) * 2u; }
    const size_t kstep = (size_t)(BK * 2);
    const size_t hstepA = (size_t)HALF * g.lda * 2, hstepB = (size_t)HALF * g.ldb * 2;
    const size_t tstepA = 2 * hstepA, tstepB = 2 * hstepB;
    const unsigned ldsw = (unsigned)wid * 1024u;
    const int aoff = lds_byte(wr * 64 + fr, fq * 8), boff = lds_byte(wc * 32 + fr, fq * 8);
#define PG8_SA(b, h) (((b) * 2 + (h)) * HTB)
#define PG8_SB(b, h) ((4 + (b) * 2 + (h)) * HTB)
#define PG8_STAGE(bufoff, gbase, voff) do { _Pragma("unroll") for (int _i = 0; _i < 2; ++_i) \
        __builtin_amdgcn_global_load_lds((const unsigned*)((const char*)(gbase) + (voff)[_i]), (LAS unsigned*)(lds + (bufoff) + ldsw + _i * 8192), 16, 0, 0); } while (0)
#define PG8_LDA(dst, b, h) do { _Pragma("unroll") for (int m = 0; m < 4; ++m) _Pragma("unroll") for (int k = 0; k < 2; ++k) dst[m][k] = *(const LAS bf16x8*)(lds + PG8_SA(b, h) + aoff + m * 2048 + k * 1024); } while (0)
#define PG8_LDB(dst, b, h) do { _Pragma("unroll") for (int n = 0; n < 2; ++n) _Pragma("unroll") for (int k = 0; k < 2; ++k) dst[n][k] = *(const LAS bf16x8*)(lds + PG8_SB(b, h) + boff + n * 2048 + k * 1024); } while (0)
#define PG8_MMA(ai, bj, At, Bt) do { __builtin_amdgcn_s_setprio(1); _Pragma("unroll") for (int m = 0; m < 4; ++m) _Pragma("unroll") for (int n = 0; n < 2; ++n) _Pragma("unroll") for (int k = 0; k < 2; ++k) \
        acc[ai][bj][m][n] = __builtin_amdgcn_mfma_f32_16x16x32_bf16(Bt[n][k], At[m][k], acc[ai][bj][m][n], 0, 0, 0); __builtin_amdgcn_s_setprio(0); } while (0)
#define PG8_WAIT_V(n) asm volatile("s_waitcnt vmcnt(" #n ")" ::: "memory")
#define PG8_WAIT_L(n) asm volatile("s_waitcnt lgkmcnt(" #n ")" ::: "memory")
#define PG8_BAR __builtin_amdgcn_s_barrier()
#define PG8_SCHED __builtin_amdgcn_sched_barrier(0)
    Unit cur, nxt; int ui = 0;
    if (!S.next(0, cur)) return;
    f32x4 acc[2][2][4][2];
#pragma unroll
    for (int a = 0; a < 2; ++a)
#pragma unroll
        for (int b = 0; b < 2; ++b)
#pragma unroll
            for (int m = 0; m < 4; ++m)
#pragma unroll
                for (int n = 0; n < 2; ++n) acc[a][b][m][n] = (f32x4){0.f, 0.f, 0.f, 0.f};
    bf16x8 At[4][2], B0[2][2], B1[2][2];
    const char* cA = (const char*)g.A + (size_t)cur.pm * tstepA + (size_t)cur.k0 * kstep; const char* cB = (const char*)g.Bt + (size_t)cur.pn * tstepB + (size_t)cur.k0 * kstep;
    PG8_STAGE(PG8_SB(0, 0), cB, voffB); PG8_STAGE(PG8_SB(0, 1), cB + hstepB, voffB); PG8_STAGE(PG8_SA(0, 0), cA, voffA); PG8_STAGE(PG8_SA(0, 1), cA + hstepA, voffA);
    if (wr == 1) PG8_BAR;
    PG8_WAIT_V(2); PG8_BAR;
    PG8_STAGE(PG8_SB(1, 0), cB + kstep, voffB); PG8_STAGE(PG8_SA(1, 0), cA + kstep, voffA); PG8_STAGE(PG8_SB(1, 1), cB + hstepB + kstep, voffB);
    PG8_WAIT_V(6); PG8_BAR;
    for (;;) {
        const bool has_next = S.next(ui + 1, nxt);
        const char* nA = has_next ? (const char*)g.A + (size_t)nxt.pm * tstepA + (size_t)nxt.k0 * kstep : cA; const char* nB = has_next ? (const char*)g.Bt + (size_t)nxt.pn * tstepB + (size_t)nxt.k0 * kstep : cB;
        const int nt = cur.nt;
        for (int t = 0; t < nt; t += 2) {
            const bool last = (t == nt - 2);
            const char* a1 = cA + (size_t)(t + 1) * kstep;
            const char* a2 = last ? nA : cA + (size_t)(t + 2) * kstep; const char* b2 = last ? nB : cB + (size_t)(t + 2) * kstep;
            const char* a3 = a2 + kstep; const char* b3 = b2 + kstep;
            PG8_LDB(B0, 0, 0); PG8_LDB(B1, 0, 1); PG8_SCHED; PG8_LDA(At, 0, 0); PG8_STAGE(PG8_SA(1, 1), a1 + hstepA, voffA);
            PG8_WAIT_V(8); PG8_WAIT_L(0); PG8_BAR; PG8_MMA(0, 0, At, B0); PG8_MMA(0, 1, At, B1); PG8_BAR; PG8_SCHED;
            PG8_LDA(At, 0, 1); PG8_STAGE(PG8_SB(0, 0), b2, voffB); PG8_STAGE(PG8_SB(0, 1), b2 + hstepB, voffB); PG8_STAGE(PG8_SA(0, 0), a2, voffA);
            PG8_WAIT_V(8); PG8_WAIT_L(0); PG8_BAR; PG8_MMA(1, 0, At, B0); PG8_MMA(1, 1, At, B1); PG8_BAR; PG8_SCHED;
            PG8_LDB(B0, 1, 0); PG8_LDB(B1, 1, 1); PG8_SCHED; PG8_LDA(At, 1, 0); PG8_STAGE(PG8_SA(0, 1), a2 + hstepA, voffA);
            PG8_WAIT_V(8); PG8_WAIT_L(0); PG8_BAR; PG8_MMA(0, 0, At, B0); PG8_MMA(0, 1, At, B1); PG8_BAR; PG8_SCHED;
            PG8_LDA(At, 1, 1); PG8_STAGE(PG8_SB(1, 0), b3, voffB); PG8_STAGE(PG8_SB(1, 1), b3 + hstepB, voffB); PG8_STAGE(PG8_SA(1, 0), a3, voffA);
            PG8_WAIT_V(8); PG8_WAIT_L(0); PG8_BAR; PG8_MMA(1, 0, At, B0); PG8_MMA(1, 1, At, B1); PG8_BAR; PG8_SCHED;
        }
        if (wr == 0) PG8_BAR;
        E(acc, cur, wr, wc, fr, fq);
        if (!has_next) break;
#pragma unroll
        for (int a = 0; a < 2; ++a)
#pragma unroll
            for (int b = 0; b < 2; ++b)
#pragma unroll
                for (int m = 0; m < 4; ++m)
#pragma unroll
                    for (int n = 0; n < 2; ++n) acc[a][b][m][n] = (f32x4){0.f, 0.f, 0.f, 0.f};
        cur = nxt; cA = nA; cB = nB; ++ui;
        if (wr == 1) PG8_BAR;
    }
    PG8_WAIT_V(0);
    PG8_BAR;
#undef PG8_SA
#undef PG8_SB
#undef PG8_STAGE
#undef PG8_LDA
#undef PG8_LDB
#undef PG8_MMA
#undef PG8_WAIT_V
#undef PG8_WAIT_L
#undef PG8_BAR
#undef PG8_SCHED
}
}

struct Args {
    const float* in[30];
    float* out;
    unsigned char* ws;
    float inv_freq[32];
    int ph_lo, ph_hi, coop, pad;
};

struct Ctx {
    LAS unsigned char* lds;
    int tid, lane, wave, gw, ngw, G;
};

enum { WK_PLAIN = 0, WK_WIN, WK_UK, WK_UV };
DI int src_col(int kind, int n) {
    switch (kind) {
        case WK_WIN: return n < 2560 ? n : (n < 3648 ? n + 16 : (n < 3664 ? n - 1088 : -1));
        case WK_UK: return (n >> 7) * 256 + (n & 127);
        case WK_UV: return (n >> 7) * 256 + 128 + (n & 127);
        default: return n;
    }
}
DI void tr_item(const float* W, int Nsrc, int sc, bf16_t* WT, int ldt, int n0, int k0, LAS float* scr, int lane) {
    float tv[32];
#pragma unroll
    for (int i = 0; i < 32; ++i) { const int kk = 2 * i + (lane >> 5); tv[i] = sc >= 0 ? W[(size_t)(k0 + kk) * Nsrc + sc] : 0.f; }
#pragma unroll
    for (int i = 0; i < 32; ++i) { const int kk = 2 * i + (lane >> 5); scr[kk * 33 + (lane & 31)] = tv[i]; }
    asm volatile("s_waitcnt lgkmcnt(0)" ::: "memory");
    const int c = lane & 7;
#pragma unroll
    for (int j = 0; j < 4; ++j) { const int n = (lane >> 3) + 8 * j; const LAS float* s = scr + (8 * c) * 33 + n;
        u32x4 o; o.x = cvtpk(s[0 * 33], s[1 * 33]); o.y = cvtpk(s[2 * 33], s[3 * 33]); o.z = cvtpk(s[4 * 33], s[5 * 33]); o.w = cvtpk(s[6 * 33], s[7 * 33]);
        *(u32x4*)(WT + (size_t)(n0 + n) * ldt + k0 + 8 * c) = o; }
    asm volatile("s_waitcnt lgkmcnt(0)" ::: "memory");
}
DI void tr_matrix_item(int r, const float* W, int Nsrc, int K, int Nd, int kind, bf16_t* WT, LAS float* scr, int lane) {
    const int nblk = Nd / 32, kb = r / nblk, nb = r % nblk, n0 = 32 * nb;
    const int sc = src_col(kind, n0 + (lane & 31));
    tr_item(W, Nsrc, sc, WT, K, n0, 64 * kb, scr, lane);
}
DI void tr_gu_item(int r, const float* Wg, const float* Wu, bf16_t* WT, LAS float* scr, int lane) {
    const int nblk = 5632 / 32, kb = r / nblk, nb = r % nblk, n0 = 32 * nb;
    const int tile = n0 >> 8, within = n0 & 255;
    const float* W = within < 128 ? Wg : Wu;
    const int sc = tile * 128 + (within & 127) + (lane & 31);
    tr_item(W, DFF, sc, WT, DM, n0, 64 * kb, scr, lane);
}
DI void p0_prologue(const Args& a, const Ctx& c) {
    LAS float* scr = (LAS float*)(c.lds + c.wave * 16384);
    unsigned char* ws = a.ws;
    constexpr int I_GU = 16 * 176, I_D = 44 * 32, I_IN = 16 * 120, I_UQ = 8 * 48, I_UK = 8 * 32, I_OUT = 32 * 32;
    constexpr int NIT = 2 * I_GU + 2 * I_D + I_IN + I_UQ + 2 * I_UK + I_OUT;
    for (int it = c.gw; it < NIT; it += c.ngw) {
        int r = it;
        if (r < I_GU) { tr_gu_item(r, a.in[8], a.in[9], (bf16_t*)(ws + WS_WGU1), scr, c.lane); continue; } r -= I_GU;
        if (r < I_GU) { tr_gu_item(r, a.in[25], a.in[26], (bf16_t*)(ws + WS_WGU2), scr, c.lane); continue; } r -= I_GU;
        if (r < I_D) { tr_matrix_item(r, a.in[10], DM, DFF, DM, WK_PLAIN, (bf16_t*)(ws + WS_WD1), scr, c.lane); continue; } r -= I_D;
        if (r < I_D) { tr_matrix_item(r, a.in[27], DM, DFF, DM, WK_PLAIN, (bf16_t*)(ws + WS_WD2), scr, c.lane); continue; } r -= I_D;
        if (r < I_IN) { tr_matrix_item(r, a.in[11], 3664, DM, NIN, WK_WIN, (bf16_t*)(ws + WS_WIN), scr, c.lane); continue; } r -= I_IN;
        if (r < I_UQ) { tr_matrix_item(r, a.in[19], 1536, 512, 1536, WK_PLAIN, (bf16_t*)(ws + WS_WUQ), scr, c.lane); continue; } r -= I_UQ;
        if (r < I_UK) { tr_matrix_item(r, a.in[21], 2048, 512, 1024, WK_UK, (bf16_t*)(ws + WS_WUK), scr, c.lane); continue; } r -= I_UK;
        if (r < I_UK) { tr_matrix_item(r, a.in[21], 2048, 512, 1024, WK_UV, (bf16_t*)(ws + WS_WUV), scr, c.lane); continue; } r -= I_UK;
        tr_matrix_item(r, a.in[22], DM, 2048, DM, WK_PLAIN, (bf16_t*)(ws + WS_WOUT), scr, c.lane);
    }
    {
        bf16_t* xb = (bf16_t*)(ws + WS_HB);
        const int gt = blockIdx.x * 512 + c.tid, ngt = c.G * 512;
        for (int i0 = gt; i0 < T * DM / 8; i0 += 4 * ngt) {
            f32x4 va[4], vb[4];
#pragma unroll
            for (int k = 0; k < 4; ++k) { const int i = i0 + k * ngt; if (i < T * DM / 8) { const size_t e = (size_t)i * 8;
                const float* src = e < (size_t)TP * DM ? a.in[0] + e : a.in[1] + (e - (size_t)TP * DM); va[k] = *(const f32x4*)src; vb[k] = *(const f32x4*)(src + 4); } }
#pragma unroll
            for (int k = 0; k < 4; ++k) { const int i = i0 + k * ngt; if (i < T * DM / 8) {
                u32x4 w; w.x = cvtpk(va[k][0], va[k][1]); w.y = cvtpk(va[k][2], va[k][3]); w.z = cvtpk(vb[k][0], vb[k][1]); w.w = cvtpk(vb[k][2], vb[k][3]);
                *(u32x4*)(xb + (size_t)i * 8) = w; } }
        }
        float* rc = (float*)(ws + WS_ROPE); float* rs = rc + 65536;
        for (int i = gt; i < 65536; i += ngt) {
            const int pos = i >> 5, k = i & 31;
            const float ang = (float)pos * a.inv_freq[k];
            const double x = (double)ang;
            const double q = rint(x * 0.6366197723675814);
            const double r = x - q * 1.5707963267948966;
            const double r2 = r * r;
            const double sn = r * (1.0 + r2 * (-1.0 / 6 + r2 * (1.0 / 120 + r2 * (-1.0 / 5040 + r2 * (1.0 / 362880 + r2 * (-1.0 / 39916800))))));
            const double cs = 1.0 + r2 * (-0.5 + r2 * (1.0 / 24 + r2 * (-1.0 / 720 + r2 * (1.0 / 40320 + r2 * (-1.0 / 3628800 + r2 * (1.0 / 479001600))))));
            const int qi = ((int)q) & 3;
            const double cc = qi == 0 ? cs : (qi == 1 ? -sn : (qi == 2 ? -cs : sn));
            const double ss = qi == 0 ? sn : (qi == 1 ? cs : (qi == 2 ? -sn : -cs));
            rc[i] = (float)cc; rs[i] = (float)ss;
        }
    }
}

struct LnRow { f32x4 v0, v1, v2, v3; };
DI void ln_finish(LnRow& r, const f32x4 (&g)[4], const f32x4 (&b)[4]) {
    float s = (r.v0[0] + r.v0[1]) + (r.v0[2] + r.v0[3]) + (r.v1[0] + r.v1[1]) + (r.v1[2] + r.v1[3]) + (r.v2[0] + r.v2[1]) + (r.v2[2] + r.v2[3]) + (r.v3[0] + r.v3[1]) + (r.v3[2] + r.v3[3]);
    const float mean = wave_sum(s) * (1.f / DM);
    r.v0 = r.v0 - mean; r.v1 = r.v1 - mean; r.v2 = r.v2 - mean; r.v3 = r.v3 - mean;
    float q = (r.v0[0] * r.v0[0] + r.v0[1] * r.v0[1]) + (r.v0[2] * r.v0[2] + r.v0[3] * r.v0[3]) + (r.v1[0] * r.v1[0] + r.v1[1] * r.v1[1]) + (r.v1[2] * r.v1[2] + r.v1[3] * r.v1[3])
            + (r.v2[0] * r.v2[0] + r.v2[1] * r.v2[1]) + (r.v2[2] * r.v2[2] + r.v2[3] * r.v2[3]) + (r.v3[0] * r.v3[0] + r.v3[1] * r.v3[1]) + (r.v3[2] * r.v3[2] + r.v3[3] * r.v3[3]);
    const float rstd = 1.0f / sqrtf(wave_sum(q) * (1.f / DM) + EPS);
    r.v0 = r.v0 * rstd * g[0] + b[0]; r.v1 = r.v1 * rstd * g[1] + b[1]; r.v2 = r.v2 * rstd * g[2] + b[2]; r.v3 = r.v3 * rstd * g[3] + b[3];
}
DI void ln_store(const LnRow& r, int row, bf16_t* hb, float* fo, int lane) {
    if (hb) {
        bf16_t* o = hb + (size_t)row * DM + 4 * lane;
        *(u32x2*)o = (u32x2){cvtpk(r.v0[0], r.v0[1]), cvtpk(r.v0[2], r.v0[3])}; *(u32x2*)(o + 256) = (u32x2){cvtpk(r.v1[0], r.v1[1]), cvtpk(r.v1[2], r.v1[3])};
        *(u32x2*)(o + 512) = (u32x2){cvtpk(r.v2[0], r.v2[1]), cvtpk(r.v2[2], r.v2[3])}; *(u32x2*)(o + 768) = (u32x2){cvtpk(r.v3[0], r.v3[1]), cvtpk(r.v3[2], r.v3[3])};
    }
    if (fo) {
        float* o = fo + (size_t)row * DM + 4 * lane;
        *(f32x4*)o = r.v0; *(f32x4*)(o + 256) = r.v1; *(f32x4*)(o + 512) = r.v2; *(f32x4*)(o + 768) = r.v3;
    }
}
DI void ln_pass(const float* R, const float* g, const float* b, bf16_t* hb, float* fo, const Ctx& c, const float* part, int S, const float* xres, const bf16_t* hres, float sc) {
    f32x4 gg[4], bb[4];
#pragma unroll
    for (int j = 0; j < 4; ++j) { gg[j] = *(const f32x4*)(g + 256 * j + 4 * c.lane); bb[j] = *(const f32x4*)(b + 256 * j + 4 * c.lane); }
    for (int row = c.gw; row < TP; row += 2 * c.ngw) {
        const int row2 = row + c.ngw; const bool has2 = row2 < TP; const int r2 = has2 ? row2 : row;
        const float* xa = R + (size_t)row * DM + 4 * c.lane; const float* xb = R + (size_t)r2 * DM + 4 * c.lane;
        LnRow A, B;
        A.v0 = *(const f32x4*)xa; A.v1 = *(const f32x4*)(xa + 256); A.v2 = *(const f32x4*)(xa + 512); A.v3 = *(const f32x4*)(xa + 768);
        B.v0 = *(const f32x4*)xb; B.v1 = *(const f32x4*)(xb + 256); B.v2 = *(const f32x4*)(xb + 512); B.v3 = *(const f32x4*)(xb + 768);
        ln_finish(A, gg, bb); ln_finish(B, gg, bb);
        ln_store(A, row, hb, fo, c.lane);
        if (has2) ln_store(B, row2, hb, fo, c.lane);
    }
    for (int row = TP + c.gw; row < T; row += c.ngw) {
        const size_t ro = (size_t)(row - TP) * DM + 4 * c.lane;
        LnRow A; A.v0 = (f32x4){0.f, 0.f, 0.f, 0.f}; A.v1 = A.v0; A.v2 = A.v0; A.v3 = A.v0;
        for (int k = 0; k < S; ++k) { const float* pp = part + (size_t)k * (TS * DM) + ro; A.v0 += *(const f32x4*)pp; A.v1 += *(const f32x4*)(pp + 256); A.v2 += *(const f32x4*)(pp + 512); A.v3 += *(const f32x4*)(pp + 768); }
        f32x4 r0, r1, r2, r3;
        if (xres) { const float* xp = xres + ro; r0 = *(const f32x4*)xp; r1 = *(const f32x4*)(xp + 256); r2 = *(const f32x4*)(xp + 512); r3 = *(const f32x4*)(xp + 768); }
        else { const bf16_t* hp = hres + (size_t)row * DM + 4 * c.lane;
            const u32x2 w0 = *(const u32x2*)hp, w1 = *(const u32x2*)(hp + 256), w2 = *(const u32x2*)(hp + 512), w3 = *(const u32x2*)(hp + 768);
            r0 = (f32x4){bflo(w0.x), bfhi(w0.x), bflo(w0.y), bfhi(w0.y)}; r1 = (f32x4){bflo(w1.x), bfhi(w1.x), bflo(w1.y), bfhi(w1.y)};
            r2 = (f32x4){bflo(w2.x), bfhi(w2.x), bflo(w2.y), bfhi(w2.y)}; r3 = (f32x4){bflo(w3.x), bfhi(w3.x), bflo(w3.y), bfhi(w3.y)}; }
        A.v0 = r0 * ALPHA + A.v0 * sc; A.v1 = r1 * ALPHA + A.v1 * sc; A.v2 = r2 * ALPHA + A.v2 * sc; A.v3 = r3 * ALPHA + A.v3 * sc;
        ln_finish(A, gg, bb);
        ln_store(A, row, hb, fo, c.lane);
    }
}

DI void post_proj(const Args& a, const Ctx& c) {
    unsigned char* ws = a.ws;
    bf16_t* MISC = (bf16_t*)(ws + A_MISC); const bf16_t* XBC = (const bf16_t*)(ws + A_XBC);
    bf16_t* MIX = (bf16_t*)(a.out + O_Y); bf16_t* BC = (bf16_t*)(ws + A_BC); float* DT = (float*)(ws + A_DT);
    const float* rc = (const float*)(ws + WS_ROPE); const float* rs = rc + 65536;
    const float* conv_w = a.in[12]; const float* conv_b = a.in[13]; const float* dt_bias = a.in[14];
    const float* qg = a.in[18]; const float* kvg = a.in[20]; const float* sconv = a.in[4];
    const int lane = c.lane;
    const f32x4 qga = *(const f32x4*)(qg + 8 * lane), qgb = *(const f32x4*)(qg + 8 * lane + 4), kga = *(const f32x4*)(kvg + 8 * lane), kgb = *(const f32x4*)(kvg + 8 * lane + 4);
    const float dtb = dt_bias[lane & 15];
    for (int r = c.gw; r < T; r += c.ngw) {
        const bool smp = r >= TP;
        const int rr = r - TP;
        const int b = smp ? (rr >> 5) : (r >> 11), t = smp ? (rr & 31) : (r & 2047), pos = smp ? 1024 + t : t, L = smp ? 32 : 2048;
        bf16_t* mrow = MISC + (size_t)r * 1280;
        const u32x4 wq = *(const u32x4*)(mrow + 8 * lane), wkv = *(const u32x4*)(mrow + 512 + 8 * lane);
        const float x1 = bf2f(mrow[1024 + (lane & 31)]), x2 = bf2f(mrow[1056 + (lane & 31)]);
        const float draw = bf2f(mrow[1088 + (lane & 15)]);
        const float cs = rc[pos * 32 + (lane & 31)], sn = rs[pos * 32 + (lane & 31)];
        u32x4 xin[3][4];
#pragma unroll
        for (int it = 0; it < 3; ++it)
#pragma unroll
            for (int k = 0; k < 4; ++k) {
                const int tt = t - 3 + k, ch = it * 512 + 8 * lane;
                if (tt >= 0) xin[it][k] = *(const u32x4*)(XBC + (size_t)(r - 3 + k) * 1536 + ch);
                else if (smp) { const float* sp = sconv + ((size_t)b * 3 + (tt + 3)) * 1536 + ch; const f32x4 xa = *(const f32x4*)sp, xb = *(const f32x4*)(sp + 4);
                    xin[it][k].x = cvtpk(xa[0], xa[1]); xin[it][k].y = cvtpk(xa[2], xa[3]); xin[it][k].z = cvtpk(xb[0], xb[1]); xin[it][k].w = cvtpk(xb[2], xb[3]); }
                else xin[it][k] = (u32x4){0u, 0u, 0u, 0u};
            }
        f32x8 vq = unpack8(wq), vk = unpack8(wkv);
        float sq = 0.f, sk = 0.f;
#pragma unroll
        for (int j = 0; j < 8; ++j) { sq += vq[j] * vq[j]; sk += vk[j] * vk[j]; }
#pragma unroll
        for (int o = 1; o < 64; o <<= 1) { sq += __shfl_xor(sq, o); sk += __shfl_xor(sk, o); }
        const float rq = 1.0f / sqrtf(sq * (1.f / 512) + EPS), rk = 1.0f / sqrtf(sk * (1.f / 512) + EPS);
#pragma unroll
        for (int j = 0; j < 4; ++j) { vq[j] = vq[j] * rq * qga[j]; vq[4 + j] = vq[4 + j] * rq * qgb[j]; vk[j] = vk[j] * rk * kga[j]; vk[4 + j] = vk[4 + j] * rk * kgb[j]; }
        u32x4 cout[3];
        int ln = lane; asm volatile("" : "+v"(ln));
#pragma unroll
        for (int it = 0; it < 3; ++it) {
            const int ch = it * 512 + 8 * ln;
            f32x8 acc; { const f32x4 ba = *(const f32x4*)(conv_b + ch), bb = *(const f32x4*)(conv_b + ch + 4); acc = (f32x8){ba[0], ba[1], ba[2], ba[3], bb[0], bb[1], bb[2], bb[3]}; }
#pragma unroll
            for (int k = 0; k < 4; ++k) {
                const f32x8 x = unpack8(xin[it][k]);
                const f32x4 wa = *(const f32x4*)(conv_w + k * 1536 + ch), wb = *(const f32x4*)(conv_w + k * 1536 + ch + 4);
#pragma unroll
                for (int j = 0; j < 4; ++j) { acc[j] += x[j] * wa[j]; acc[4 + j] += x[4 + j] * wb[j]; }
            }
#pragma unroll
            for (int j = 0; j < 8; ++j) acc[j] = silu_f(acc[j]);
            cout[it] = pack8(acc);
        }
        *(u32x4*)(mrow + 8 * lane) = pack8(vq);
        *(u32x4*)(mrow + 512 + 8 * lane) = pack8(vk);
        {
            float* lo = smp ? a.out + O_LATS + (size_t)rr * 512 : a.out + O_LATP + (size_t)r * 512;
            *(f32x4*)(lo + 8 * lane) = (f32x4){vk[0], vk[1], vk[2], vk[3]}; *(f32x4*)(lo + 8 * lane + 4) = (f32x4){vk[4], vk[5], vk[6], vk[7]};
        }
        if (lane < 32) {
            const float o1 = x1 * cs - x2 * sn, o2 = x1 * sn + x2 * cs;
            float* ko = smp ? a.out + O_KRS + (size_t)rr * 64 : a.out + O_KRP + (size_t)r * 64;
            ko[lane] = o1; ko[32 + lane] = o2;
            mrow[1024 + lane] = (bf16_t)(cvtpk(o1, 0.f) & 0xffffu); mrow[1056 + lane] = (bf16_t)(cvtpk(o2, 0.f) & 0xffffu);
        } else if (lane < 48) {
            const float v = draw + dtb;
            DT[(size_t)r * 16 + (lane - 32)] = fmaxf(v, 0.f) + log1pf(expf(-fabsf(v)));
        }
        *(u32x4*)(MIX + (size_t)r * 2048 + 8 * lane) = cout[0];
        *(u32x4*)(MIX + (size_t)r * 2048 + 512 + 8 * lane) = cout[1];
        *(u32x4*)(BC + (size_t)r * 512 + 8 * lane) = cout[2];
        if (t >= L - 3) {
#pragma unroll
            for (int it = 0; it < 3; ++it) {
                const int ch = it * 512 + 8 * lane;
                const f32x8 cur = unpack8(xin[it][3]);
                float* co = smp ? a.out + O_CONVS + ((size_t)b * 3 + (t - (L - 3))) * 1536 + ch : a.out + O_CONVP + ((size_t)b * 3 + (t - (L - 3))) * 1536 + ch;
                *(f32x4*)co = (f32x4){cur[0], cur[1], cur[2], cur[3]}; *(f32x4*)(co + 4) = (f32x4){cur[4], cur[5], cur[6], cur[7]};
            }
        }
    }
}

constexpr int SB_ROW = 272, SX_ROW = 1040;
constexpr int L_BS = 0, L_CS = 64 * SB_ROW, L_XS = 2 * 64 * SB_ROW, L_WS = L_XS + 64 * SX_ROW;
DI void ssd_decode_item(int it, int& row0, int& nib, int& g, int& b, int& sbase, bool& smp) {
    if (it < 512) { b = it >> 6; const int ch = (it >> 1) & 31; g = it & 1; row0 = b * 2048 + 64 * ch; nib = 2; sbase = (b * 32 + ch) * 16; smp = false; }
    else { const int j = it - 512; b = j >> 1; g = j & 1; row0 = TP + 32 * b; nib = 1; sbase = 4096 + b * 16; smp = true; }
}
DI void ssd_load_chunk(const Ctx& c, const bf16_t* BC, const bf16_t* MIX, int row0, int nrows, int g, bool needC) {
    LAS unsigned char* L = c.lds;
    u32x4 vb[2], vc[2], vx[8];
#pragma unroll
    for (int k = 0; k < 2; ++k) { const int i = c.tid + 512 * k, r = i >> 4, cc = i & 15;
        if (r < nrows) { vb[k] = *(const u32x4*)(BC + (size_t)(row0 + r) * 512 + g * 128 + cc * 8); if (needC) vc[k] = *(const u32x4*)(BC + (size_t)(row0 + r) * 512 + 256 + g * 128 + cc * 8); } }
#pragma unroll
    for (int k = 0; k < 8; ++k) { const int i = c.tid + 512 * k, r = i >> 6, cc = i & 63;
        if (r < nrows) vx[k] = *(const u32x4*)(MIX + (size_t)(row0 + r) * 2048 + g * 512 + cc * 8); }
#pragma unroll
    for (int k = 0; k < 2; ++k) { const int i = c.tid + 512 * k, r = i >> 4, cc = i & 15;
        if (r < nrows) { *(LAS u32x4*)(L + L_BS + r * SB_ROW + cc * 16) = vb[k]; if (needC) *(LAS u32x4*)(L + L_CS + r * SB_ROW + cc * 16) = vc[k]; } }
#pragma unroll
    for (int k = 0; k < 8; ++k) { const int i = c.tid + 512 * k, r = i >> 6, cc = i & 63;
        if (r < nrows) *(LAS u32x4*)(L + L_XS + r * SX_ROW + cc * 16) = vx[k]; }
}
DI void ssd_a(const Args& a, const Ctx& c) {
    unsigned char* ws = a.ws;
    const bf16_t* MIX = (const bf16_t*)(a.out + O_Y); const bf16_t* BC = (const bf16_t*)(ws + A_BC); const float* DT = (const float*)(ws + A_DT);
    bf16_t* ST = (bf16_t*)(ws + A_ST); float* DEC = (float*)(ws + A_DEC);
    const float* a_log = a.in[15];
    LAS unsigned char* L = c.lds;
    LAS float* wsm = (LAS float*)(L + L_WS + c.wave * 512);
    const int lane = c.lane, r = lane & 31, kg = lane >> 5, w = c.wave;
    for (int it = blockIdx.x; it < 544; it += c.G) {
        int row0, nib, g, b, sbase; bool smp;
        ssd_decode_item(it, row0, nib, g, b, sbase, smp);
        const int nj = 32 * nib, h = 8 * g + w, item = sbase + h;
        ssd_load_chunk(c, BC, MIX, row0, nj, g, false);
        const float dtv = lane < nj ? DT[(size_t)(row0 + lane) * 16 + h] : 0.f;
        const float Ah = -expf(a_log[h]);
        float acs = dtv * Ah;
#pragma unroll
        for (int d = 1; d < 64; d <<= 1) { const float tv = __shfl_up(acs, d); if (lane >= d) acs += tv; }
        const float alast = __shfl(acs, nj - 1);
        wsm[lane] = dtv * expf(alast - acs);
        if (lane == 0) DEC[item] = expf(alast);
        __syncthreads();
        f32x16 acc[2][4];
#pragma unroll
        for (int pb = 0; pb < 2; ++pb)
#pragma unroll
            for (int nb = 0; nb < 4; ++nb)
#pragma unroll
                for (int e = 0; e < 16; ++e) acc[pb][nb][e] = 0.f;
        const int ns = nj >> 4;
        for (int s = 0; s < ns; ++s) {
            const int j0 = 16 * s + 8 * kg;
            f32x8 wv;
#pragma unroll
            for (int jj = 0; jj < 8; ++jj) wv[jj] = wsm[j0 + jj];
            bf16x8 af[2];
#pragma unroll
            for (int pb = 0; pb < 2; ++pb) {
                f32x8 x;
#pragma unroll
                for (int jj = 0; jj < 8; ++jj) x[jj] = bf2f(*(const LAS bf16_t*)(L + L_XS + (j0 + jj) * SX_ROW + (w * 64 + 32 * pb + r) * 2)) * wv[jj];
                af[pb] = __builtin_bit_cast(bf16x8, pack8(x));
            }
#pragma unroll
            for (int nb = 0; nb < 4; ++nb) {
                bf16x8 bfr;
#pragma unroll
                for (int jj = 0; jj < 8; ++jj) bfr[jj] = (short)*(const LAS bf16_t*)(L + L_BS + (j0 + jj) * SB_ROW + (32 * nb + r) * 2);
                acc[0][nb] = MFMA32(af[0], bfr, acc[0][nb]);
                acc[1][nb] = MFMA32(af[1], bfr, acc[1][nb]);
            }
        }
        __syncthreads();
        LAS unsigned char* stg = L + w * 16384;
#pragma unroll
        for (int pb = 0; pb < 2; ++pb)
#pragma unroll
            for (int nb = 0; nb < 4; ++nb)
#pragma unroll
                for (int e = 0; e < 16; ++e) *(LAS bf16_t*)(stg + ((32 * pb + crow(e, kg)) * 128 + 32 * nb + r) * 2) = (bf16_t)(cvtpk(acc[pb][nb][e], 0.f) & 0xffffu);
        asm volatile("s_waitcnt lgkmcnt(0)" ::: "memory");
        bf16_t* so = ST + (size_t)item * 8192;
#pragma unroll
        for (int k = 0; k < 16; ++k) *(u32x4*)(so + (k * 64 + lane) * 8) = *(const LAS u32x4*)(stg + (k * 64 + lane) * 16);
        __syncthreads();
    }
}
DI void ssd_scan(const Args& a, const Ctx& c) {
    unsigned char* ws = a.ws;
    bf16_t* ST = (bf16_t*)(ws + A_ST); const float* DEC = (const float*)(ws + A_DEC);
    const int gt = blockIdx.x * 512 + c.tid, ngt = c.G * 512;
    for (int i = gt; i < 131072; i += ngt) {
        const int b = i >> 14, h = (i >> 10) & 15, e = (i & 1023) * 8;
        f32x8 hv = (f32x8){0.f, 0.f, 0.f, 0.f, 0.f, 0.f, 0.f, 0.f};
        for (int cb = 0; cb < 32; cb += 8) {
            u32x4 sv[8]; float dec[8];
#pragma unroll
            for (int k = 0; k < 8; ++k) { const int item = (b * 32 + cb + k) * 16 + h; sv[k] = *(const u32x4*)(ST + (size_t)item * 8192 + e); dec[k] = DEC[item]; }
#pragma unroll
            for (int k = 0; k < 8; ++k) { const int item = (b * 32 + cb + k) * 16 + h; *(u32x4*)(ST + (size_t)item * 8192 + e) = pack8(hv); hv = hv * dec[k] + unpack8(sv[k]); }
        }
        float* o = a.out + O_SSMP + (size_t)(b * 16 + h) * 8192 + e;
        *(f32x4*)o = (f32x4){hv[0], hv[1], hv[2], hv[3]}; *(f32x4*)(o + 4) = (f32x4){hv[4], hv[5], hv[6], hv[7]};
    }
    const float* h0 = a.in[5];
    for (int i = gt; i < 262144; i += ngt) {
        const int bh = i >> 10, e = (i & 1023) * 8;
        const float* hp = h0 + (size_t)bh * 8192 + e;
        const f32x4 ha = *(const f32x4*)hp, hb = *(const f32x4*)(hp + 4);
        const f32x8 sv = unpack8(*(const u32x4*)(ST + (size_t)(4096 + bh) * 8192 + e));
        const float dec = DEC[4096 + bh];
        float* o = a.out + O_SSMS + (size_t)bh * 8192 + e;
        *(f32x4*)o = (f32x4){ha[0] * dec + sv[0], ha[1] * dec + sv[1], ha[2] * dec + sv[2], ha[3] * dec + sv[3]};
        *(f32x4*)(o + 4) = (f32x4){hb[0] * dec + sv[4], hb[1] * dec + sv[5], hb[2] * dec + sv[6], hb[3] * dec + sv[7]};
    }
}
DI void ssd_c(const Args& a, const Ctx& c) {
    unsigned char* ws = a.ws;
    bf16_t* MIX = (bf16_t*)(a.out + O_Y); const bf16_t* BC = (const bf16_t*)(ws + A_BC); const float* DT = (const float*)(ws + A_DT);
    const bf16_t* ST = (const bf16_t*)(ws + A_ST); const bf16_t* Z = (const bf16_t*)(ws + A_Z);
    const float* a_log = a.in[15]; const float* d_skip = a.in[16]; const float* ng = a.in[17]; const float* h0 = a.in[5];
    LAS unsigned char* L = c.lds;
    LAS float* wacs = (LAS float*)(L + L_WS + c.wave * 512); LAS float* wdt = wacs + 64;
    LAS float* part = (LAS float*)(L + L_WS + 4096);
    const int lane = c.lane, il = lane & 31, hi = lane >> 5, w = c.wave;
    for (int it = blockIdx.x; it < 544; it += c.G) {
        int row0, nib, g, b, sbase; bool smp;
        ssd_decode_item(it, row0, nib, g, b, sbase, smp);
        const int h = 8 * g + w, nj = 32 * nib;
        ssd_load_chunk(c, BC, MIX, row0, nj, g, true);
        const float dtv = lane < nj ? DT[(size_t)(row0 + lane) * 16 + h] : 0.f;
        const float Ah = -expf(a_log[h]);
        float acs = dtv * Ah;
#pragma unroll
        for (int d = 1; d < 64; d <<= 1) { const float tv = __shfl_up(acs, d); if (lane >= d) acs += tv; }
        wacs[lane] = acs; wdt[lane] = dtv;
        __syncthreads();
        f32x16 Y[2][2];
#pragma unroll
        for (int pb = 0; pb < 2; ++pb)
#pragma unroll
            for (int ib = 0; ib < 2; ++ib)
#pragma unroll
                for (int e = 0; e < 16; ++e) Y[pb][ib][e] = 0.f;
        const LAS unsigned char* cl0 = L + L_CS + il * SB_ROW + 16 * hi;
        if (!smp) {
            const bf16_t* hp = ST + (size_t)(sbase + h) * 8192 + (size_t)il * 128 + 8 * hi;
#pragma unroll 4
            for (int s = 0; s < 8; ++s) {
                const bf16x8 af0 = *(const bf16x8*)(hp + 16 * s), af1 = *(const bf16x8*)(hp + 32 * 128 + 16 * s);
                const bf16x8 c0 = *(const LAS bf16x8*)(cl0 + 32 * s), c1 = *(const LAS bf16x8*)(cl0 + 32 * SB_ROW + 32 * s);
                Y[0][0] = MFMA32(af0, c0, Y[0][0]); Y[1][0] = MFMA32(af1, c0, Y[1][0]);
                Y[0][1] = MFMA32(af0, c1, Y[0][1]); Y[1][1] = MFMA32(af1, c1, Y[1][1]);
            }
        } else {
            const float* hp = h0 + (size_t)(sbase - 4096 + h) * 8192 + (size_t)il * 128 + 8 * hi;
#pragma unroll 2
            for (int s = 0; s < 8; ++s) {
                bf16x8 af[2];
#pragma unroll
                for (int pb = 0; pb < 2; ++pb) { const f32x4 x0 = *(const f32x4*)(hp + pb * 4096 + 16 * s), x1 = *(const f32x4*)(hp + pb * 4096 + 16 * s + 4);
                    u32x4 pk; pk.x = cvtpk(x0[0], x0[1]); pk.y = cvtpk(x0[2], x0[3]); pk.z = cvtpk(x1[0], x1[1]); pk.w = cvtpk(x1[2], x1[3]); af[pb] = __builtin_bit_cast(bf16x8, pk); }
                const bf16x8 c0 = *(const LAS bf16x8*)(cl0 + 32 * s);
                Y[0][0] = MFMA32(af[0], c0, Y[0][0]); Y[1][0] = MFMA32(af[1], c0, Y[1][0]);
            }
        }
        {
            const float ea0 = expf(wacs[il]), ea1 = expf(wacs[32 + il]);
#pragma unroll
            for (int e = 0; e < 16; ++e) { Y[0][0][e] *= ea0; Y[1][0][e] *= ea0; Y[0][1][e] *= ea1; Y[1][1][e] *= ea1; }
        }
        for (int jb = 0; jb < nib; ++jb) {
            f32x16 MT[2];
#pragma unroll
            for (int e = 0; e < 16; ++e) { MT[0][e] = 0.f; MT[1][e] = 0.f; }
            const LAS unsigned char* bl = L + L_BS + (32 * jb + il) * SB_ROW + 16 * hi;
#pragma unroll
            for (int s = 0; s < 8; ++s) {
                const bf16x8 bf_ = *(const LAS bf16x8*)(bl + 32 * s);
                if (jb == 0) { const bf16x8 c0 = *(const LAS bf16x8*)(cl0 + 32 * s); MT[0] = MFMA32(bf_, c0, MT[0]); }
                if (nib == 2) { const bf16x8 c1 = *(const LAS bf16x8*)(cl0 + 32 * SB_ROW + 32 * s); MT[1] = MFMA32(bf_, c1, MT[1]); }
            }
            const float ai0 = wacs[il], ai1 = wacs[32 + il];
#pragma unroll
            for (int e = 0; e < 16; ++e) {
                const int jl = crow(e, hi), j = 32 * jb + jl;
                const float aj = wacs[j], dj = wdt[j];
                if (jb == 0) {
                    MT[0][e] *= (jl <= il) ? expf(ai0 - aj) * dj : 0.f;
                    MT[1][e] *= expf(fminf(ai1 - aj, 0.f)) * dj;
                } else {
                    MT[1][e] *= (jl <= il) ? expf(ai1 - aj) * dj : 0.f;
                }
            }
#pragma unroll
            for (int s2 = 0; s2 < 2; ++s2) {
                u32x4 p0, p1;
                p0.x = cvtpk(MT[0][8 * s2 + 0], MT[0][8 * s2 + 1]); p0.y = cvtpk(MT[0][8 * s2 + 2], MT[0][8 * s2 + 3]); p0.z = cvtpk(MT[0][8 * s2 + 4], MT[0][8 * s2 + 5]); p0.w = cvtpk(MT[0][8 * s2 + 6], MT[0][8 * s2 + 7]);
                p1.x = cvtpk(MT[1][8 * s2 + 0], MT[1][8 * s2 + 1]); p1.y = cvtpk(MT[1][8 * s2 + 2], MT[1][8 * s2 + 3]); p1.z = cvtpk(MT[1][8 * s2 + 4], MT[1][8 * s2 + 5]); p1.w = cvtpk(MT[1][8 * s2 + 6], MT[1][8 * s2 + 7]);
                const bf16x8 pf0 = __builtin_bit_cast(bf16x8, p0), pf1 = __builtin_bit_cast(bf16x8, p1);
#pragma unroll
                for (int pb = 0; pb < 2; ++pb) {
                    bf16x8 af;
#pragma unroll
                    for (int jj = 0; jj < 8; ++jj) { const int j = 32 * jb + 16 * s2 + 8 * (jj >> 2) + 4 * hi + (jj & 3); af[jj] = (short)*(const LAS bf16_t*)(L + L_XS + j * SX_ROW + (w * 64 + 32 * pb + il) * 2); }
                    if (jb == 0) Y[pb][0] = MFMA32(af, pf0, Y[pb][0]);
                    if (nib == 2) Y[pb][1] = MFMA32(af, pf1, Y[pb][1]);
                }
            }
        }
        const float dsk = d_skip[h];
        float ssq0 = 0.f, ssq1 = 0.f;
#pragma unroll
        for (int ib = 0; ib < 2; ++ib) {
            if (ib < nib) {
                const size_t row = (size_t)(row0 + 32 * ib + il);
#pragma unroll
                for (int pb = 0; pb < 2; ++pb)
#pragma unroll
                    for (int gq = 0; gq < 4; ++gq) {
                        const int p0 = 32 * pb + 8 * gq + 4 * hi;
                        const u32x2 xw = *(const LAS u32x2*)(L + L_XS + (32 * ib + il) * SX_ROW + (w * 64 + p0) * 2), zw = *(const u32x2*)(Z + row * 1024 + h * 64 + p0);
                        const float xv[4] = {bflo(xw.x), bfhi(xw.x), bflo(xw.y), bfhi(xw.y)}, zv[4] = {bflo(zw.x), bfhi(zw.x), bflo(zw.y), bfhi(zw.y)};
#pragma unroll
                        for (int e = 0; e < 4; ++e) { float y = Y[pb][ib][4 * gq + e] + dsk * xv[e]; y *= silu_f(zv[e]); Y[pb][ib][4 * gq + e] = y; if (ib == 0) ssq0 += y * y; else ssq1 += y * y; }
                    }
            }
        }
        ssq0 += __shfl_xor(ssq0, 32); ssq1 += __shfl_xor(ssq1, 32);
        if (hi == 0) { part[w * 64 + il] = ssq0; part[w * 64 + 32 + il] = ssq1; }
        __syncthreads();
        float t0 = 0.f, t1 = 0.f;
#pragma unroll
        for (int ww = 0; ww < 8; ++ww) { t0 += part[ww * 64 + il]; t1 += part[ww * 64 + 32 + il]; }
        const float rs0 = 1.0f / sqrtf(t0 * (1.f / 512) + EPS), rs1 = 1.0f / sqrtf(t1 * (1.f / 512) + EPS);
#pragma unroll
        for (int ib = 0; ib < 2; ++ib) {
            if (ib < nib) {
                const size_t row = (size_t)(row0 + 32 * ib + il);
                const float rs = ib == 0 ? rs0 : rs1;
#pragma unroll
                for (int pb = 0; pb < 2; ++pb)
#pragma unroll
                    for (int gq = 0; gq < 4; ++gq) {
                        const int p0 = 32 * pb + 8 * gq + 4 * hi;
                        const f32x4 gn = *(const f32x4*)(ng + h * 64 + p0);
                        u32x2 o; o.x = cvtpk(Y[pb][ib][4 * gq + 0] * rs * gn[0], Y[pb][ib][4 * gq + 1] * rs * gn[1]); o.y = cvtpk(Y[pb][ib][4 * gq + 2] * rs * gn[2], Y[pb][ib][4 * gq + 3] * rs * gn[3]);
                        *(u32x2*)(MIX + row * 2048 + h * 64 + p0) = o;
                    }
            }
        }
        __syncthreads();
    }
}

DI void load_q_frags(bf16x8 (&qf)[12], const bf16_t* Qrow, int ldq, const float* rc, const float* rs, int pos0, int lane) {
    const int q = lane & 31, hi = lane >> 5;
    constexpr float SC = 0.07216878364870322f * 1.4426950408889634f;
    const bf16_t* qp = Qrow + (size_t)q * ldq + 8 * hi;
#pragma unroll
    for (int s = 0; s < 8; ++s) { f32x8 v = unpack8(*(const u32x4*)(qp + 16 * s)); v = v * SC; qf[s] = __builtin_bit_cast(bf16x8, pack8(v)); }
    const float* cp = rc + (size_t)(pos0 + q) * 32; const float* sp = rs + (size_t)(pos0 + q) * 32;
#pragma unroll
    for (int s = 0; s < 2; ++s) {
        const f32x8 x1 = unpack8(*(const u32x4*)(qp + 128 + 16 * s)), x2 = unpack8(*(const u32x4*)(qp + 160 + 16 * s));
        const int i0 = 16 * s + 8 * hi;
        f32x8 o1, o2;
#pragma unroll
        for (int jj = 0; jj < 8; ++jj) { const float cs = cp[i0 + jj], sn = sp[i0 + jj]; o1[jj] = (x1[jj] * cs - x2[jj] * sn) * SC; o2[jj] = (x1[jj] * sn + x2[jj] * cs) * SC; }
        qf[8 + s] = __builtin_bit_cast(bf16x8, pack8(o1)); qf[10 + s] = __builtin_bit_cast(bf16x8, pack8(o2));
    }
}
DI void softmax_step(f32x16& st, float& m, float& l, f32x16& o0, f32x16& o1, f32x16& o2, f32x16& o3, bf16x8& pf0, bf16x8& pf1) {
    float mx = st[0];
#pragma unroll
    for (int e = 1; e < 16; ++e) mx = fmaxf(mx, st[e]);
    mx = fmaxf(mx, __shfl_xor(mx, 32));
    const float mn = fmaxf(m, mx);
    const float alpha = __builtin_amdgcn_exp2f(m - mn);
    m = mn;
    float ps = 0.f;
#pragma unroll
    for (int e = 0; e < 16; ++e) { st[e] = __builtin_amdgcn_exp2f(st[e] - mn); ps += st[e]; }
    l = l * alpha + ps;
    o0 = o0 * alpha; o1 = o1 * alpha; o2 = o2 * alpha; o3 = o3 * alpha;
    u32x4 p0, p1;
    p0.x = cvtpk(st[0], st[1]); p0.y = cvtpk(st[2], st[3]); p0.z = cvtpk(st[4], st[5]); p0.w = cvtpk(st[6], st[7]);
    p1.x = cvtpk(st[8], st[9]); p1.y = cvtpk(st[10], st[11]); p1.z = cvtpk(st[12], st[13]); p1.w = cvtpk(st[14], st[15]);
    pf0 = __builtin_bit_cast(bf16x8, p0); pf1 = __builtin_bit_cast(bf16x8, p1);
}
DI void store_o(bf16_t* Oout, int ldo, int lane, float inv, const f32x16& o0, const f32x16& o1, const f32x16& o2, const f32x16& o3) {
    const int q = lane & 31, hi = lane >> 5;
    bf16_t* op = Oout + (size_t)q * ldo + 4 * hi;
#pragma unroll
    for (int gq = 0; gq < 4; ++gq) {
        *(u32x2*)(op + 0 + 8 * gq) = (u32x2){cvtpk(o0[4 * gq] * inv, o0[4 * gq + 1] * inv), cvtpk(o0[4 * gq + 2] * inv, o0[4 * gq + 3] * inv)};
        *(u32x2*)(op + 32 + 8 * gq) = (u32x2){cvtpk(o1[4 * gq] * inv, o1[4 * gq + 1] * inv), cvtpk(o1[4 * gq + 2] * inv, o1[4 * gq + 3] * inv)};
        *(u32x2*)(op + 64 + 8 * gq) = (u32x2){cvtpk(o2[4 * gq] * inv, o2[4 * gq + 1] * inv), cvtpk(o2[4 * gq + 2] * inv, o2[4 * gq + 3] * inv)};
        *(u32x2*)(op + 96 + 8 * gq) = (u32x2){cvtpk(o3[4 * gq] * inv, o3[4 * gq + 1] * inv), cvtpk(o3[4 * gq + 2] * inv, o3[4 * gq + 3] * inv)};
    }
}
constexpr int KROW = 400, VROW = 144, KT_BYTES = 64 * KROW, VT_BYTES = 128 * VROW, STG_BYTES = KT_BYTES + VT_BYTES;
DI void attn_unit_prompt(int b, int h, int u, const Args& a, const Ctx& c) {
    unsigned char* ws = a.ws;
    const bf16_t* Q = (const bf16_t*)(ws + A_Q); const bf16_t* KN = (const bf16_t*)(ws + A_KN); const bf16_t* VT = (const bf16_t*)(ws + A_VT);
    const bf16_t* KR = (const bf16_t*)(ws + A_MISC) + 1024; bf16_t* MIX = (bf16_t*)(a.out + O_Y);
    const float* rc = (const float*)(ws + WS_ROPE); const float* rs = rc + 65536;
    const int tid = c.tid, lane = c.lane, w = c.wave, q = lane & 31, hi = lane >> 5;
    const int krow0 = b * 2048, row_q0 = krow0 + 256 * u + 32 * w;
    const int NT = 4 * u + 4, mylim = 4 * u + (w >> 1) + 1;
    const char* bKN = (const char*)(KN + (size_t)krow0 * 1024 + h * 128);
    const char* bKR = (const char*)(KR + (size_t)krow0 * 1280);
    const char* bVT = (const char*)(VT + (size_t)(h * 128) * TKS + krow0);
    u32x4 stg[5];
#define ATT_LOAD() do { int tt = tid; asm volatile("" : "+v"(tt)); \
        stg[0] = *(const u32x4*)(bKN + (unsigned)((tt >> 4) * 2048 + (tt & 15) * 16)); stg[1] = *(const u32x4*)(bKN + (unsigned)(((tt >> 4) + 32) * 2048 + (tt & 15) * 16)); \
        stg[2] = *(const u32x4*)(bKR + (unsigned)((tt >> 3) * 2560 + (tt & 7) * 16)); \
        stg[3] = *(const u32x4*)(bVT + (unsigned)((tt >> 3) * (TKS * 2) + (tt & 7) * 16)); stg[4] = *(const u32x4*)(bVT + (unsigned)(((tt >> 3) + 64) * (TKS * 2) + (tt & 7) * 16)); \
        bKN += 64 * 2048; bKR += 64 * 2560; bVT += 128; } while (0)
#define ATT_WRITE(base) do { int tt = tid; asm volatile("" : "+v"(tt)); LAS unsigned char* wb = L + (base); \
        *(LAS u32x4*)(wb + (tt >> 4) * KROW + (tt & 15) * 16) = stg[0]; *(LAS u32x4*)(wb + ((tt >> 4) + 32) * KROW + (tt & 15) * 16) = stg[1]; \
        *(LAS u32x4*)(wb + (tt >> 3) * KROW + 256 + (tt & 7) * 16) = stg[2]; \
        *(LAS u32x4*)(wb + KT_BYTES + (tt >> 3) * VROW + (tt & 7) * 16) = stg[3]; *(LAS u32x4*)(wb + KT_BYTES + ((tt >> 3) + 64) * VROW + (tt & 7) * 16) = stg[4]; } while (0)
    LAS unsigned char* L = c.lds;
    ATT_LOAD();
    bf16x8 qf[12];
    load_q_frags(qf, Q + (size_t)row_q0 * 1536 + h * 192, 1536, rc, rs, 256 * u + 32 * w, lane);
    f32x16 o0, o1, o2, o3;
#pragma unroll
    for (int e = 0; e < 16; ++e) { o0[e] = 0.f; o1[e] = 0.f; o2[e] = 0.f; o3[e] = 0.f; }
    float m = -1e30f, l = 0.f;
    const int pi = (q & ~12) | ((q & 4) << 1) | ((q & 8) >> 1);
    const unsigned koff = (unsigned)(pi * KROW + 16 * hi), voff = (unsigned)(KT_BYTES + q * VROW + 16 * hi);
    ATT_WRITE(0);
    __syncthreads();
    for (int t = 0; t < NT; ++t) {
        const unsigned cur = (unsigned)(t & 1) * STG_BYTES, nxt = (unsigned)((t + 1) & 1) * STG_BYTES;
        const bool more = t + 1 < NT;
        if (more) ATT_LOAD();
        if (t < mylim) {
#pragma unroll
            for (int sub = 0; sub < 2; ++sub) {
                const LAS unsigned char* kb = L + cur + koff + sub * 32 * KROW;
                f32x16 st;
#pragma unroll
                for (int e = 0; e < 16; ++e) st[e] = 0.f;
#pragma unroll
                for (int s = 0; s < 12; ++s) { const bf16x8 kf = *(const LAS bf16x8*)(kb + 32 * s); st = MFMA32(kf, qf[s], st); if ((s & 3) == 3) asm volatile("" ::: "memory"); }
                bf16x8 pf0, pf1;
                softmax_step(st, m, l, o0, o1, o2, o3, pf0, pf1);
                asm volatile("" ::: "memory");
                const LAS unsigned char* vb = L + cur + voff + sub * 64;
                { const bf16x8 v0 = *(const LAS bf16x8*)(vb), v1 = *(const LAS bf16x8*)(vb + 32); o0 = MFMA32(v0, pf0, o0); o0 = MFMA32(v1, pf1, o0); }
                { const bf16x8 v0 = *(const LAS bf16x8*)(vb + 32 * VROW), v1 = *(const LAS bf16x8*)(vb + 32 * VROW + 32); o1 = MFMA32(v0, pf0, o1); o1 = MFMA32(v1, pf1, o1); }
                { const bf16x8 v0 = *(const LAS bf16x8*)(vb + 64 * VROW), v1 = *(const LAS bf16x8*)(vb + 64 * VROW + 32); o2 = MFMA32(v0, pf0, o2); o2 = MFMA32(v1, pf1, o2); }
                { const bf16x8 v0 = *(const LAS bf16x8*)(vb + 96 * VROW), v1 = *(const LAS bf16x8*)(vb + 96 * VROW + 32); o3 = MFMA32(v0, pf0, o3); o3 = MFMA32(v1, pf1, o3); }
                asm volatile("" ::: "memory");
            }
        }
        if (more) ATT_WRITE(nxt);
        __syncthreads();
    }
    l += __shfl_xor(l, 32);
    store_o(MIX + (size_t)row_q0 * 2048 + 1024 + h * 128, 2048, lane, 1.0f / l, o0, o1, o2, o3);
#undef ATT_LOAD
#undef ATT_WRITE
}
DI void attn_prompt(const Args& a, const Ctx& c) {
    for (int p = blockIdx.x; p < 256; p += c.G) {
        const int b = p >> 5, h = (p >> 2) & 7, uu = p & 3;
#pragma unroll 1
        for (int k = 0; k < 2; ++k) attn_unit_prompt(b, h, k == 0 ? 7 - uu : uu, a, c);
    }
}
DI void attn_sample(const Args& a, const Ctx& c) {
    unsigned char* ws = a.ws;
    const bf16_t* Q = (const bf16_t*)(ws + A_Q); const bf16_t* KN = (const bf16_t*)(ws + A_KN); const bf16_t* VT = (const bf16_t*)(ws + A_VT);
    const bf16_t* KR = (const bf16_t*)(ws + WS_KRS); bf16_t* MIX = (bf16_t*)(a.out + O_Y);
    const float* rc = (const float*)(ws + WS_ROPE); const float* rs = rc + 65536;
    const int lane = c.lane, w = c.wave, q = lane & 31, hi = lane >> 5;
    LAS float* part = (LAS float*)c.lds;
    LAS float* ml = (LAS float*)(c.lds + 131072 + 1024);
    for (int it = blockIdx.x; it < 128; it += c.G) {
        const int b = it >> 3, h = it & 7;
        const int row_q0 = TP + 32 * b, krow0 = b * 1024;
        bf16x8 qf[12];
        load_q_frags(qf, Q + (size_t)row_q0 * 1536 + h * 192, 1536, rc, rs, 1024, lane);
        f32x16 o0, o1, o2, o3;
#pragma unroll
        for (int e = 0; e < 16; ++e) { o0[e] = 0.f; o1[e] = 0.f; o2[e] = 0.f; o3[e] = 0.f; }
        float m = -1e30f, l = 0.f;
        const int kt0 = (33 * w) >> 3, kt1 = (33 * (w + 1)) >> 3;
        const int pi = (q & ~12) | ((q & 4) << 1) | ((q & 8) >> 1);
        const bf16_t* kp = KN + (size_t)(krow0 + 32 * kt0 + pi) * 1024 + h * 128 + 8 * hi;
        const bf16_t* krp = KR + (size_t)(krow0 + 32 * kt0 + pi) * 64 + 8 * hi;
        const bf16_t* vp = VT + (size_t)(h * 128 + q) * TKS + krow0 + 32 * kt0 + 8 * hi;
        size_t vstride = (size_t)32 * TKS;
        for (int kt = kt0; kt < kt1; ++kt) {
            if (kt == 32) {
                kp = (const bf16_t*)(ws + A_KNN) + (size_t)(32 * b + pi) * 1024 + h * 128 + 8 * hi;
                krp = (const bf16_t*)(ws + A_MISC) + (size_t)(TP + 32 * b + pi) * 1280 + 1024 + 8 * hi;
                vp = (const bf16_t*)(ws + A_VTN) + (size_t)(h * 128 + q) * 512 + 32 * b + 8 * hi;
                vstride = (size_t)32 * 512;
            }
            bf16x8 kf[12];
#pragma unroll
            for (int s = 0; s < 8; ++s) kf[s] = *(const bf16x8*)(kp + 16 * s);
#pragma unroll
            for (int s = 0; s < 4; ++s) kf[8 + s] = *(const bf16x8*)(krp + 16 * s);
            bf16x8 vf[4][2];
#pragma unroll
            for (int blk = 0; blk < 4; ++blk) { vf[blk][0] = *(const bf16x8*)(vp + blk * vstride); vf[blk][1] = *(const bf16x8*)(vp + blk * vstride + 16); }
            f32x16 st;
#pragma unroll
            for (int e = 0; e < 16; ++e) st[e] = 0.f;
#pragma unroll
            for (int s = 0; s < 12; ++s) st = MFMA32(kf[s], qf[s], st);
            bf16x8 pf0, pf1;
            softmax_step(st, m, l, o0, o1, o2, o3, pf0, pf1);
            o0 = MFMA32(vf[0][0], pf0, o0); o0 = MFMA32(vf[0][1], pf1, o0);
            o1 = MFMA32(vf[1][0], pf0, o1); o1 = MFMA32(vf[1][1], pf1, o1);
            o2 = MFMA32(vf[2][0], pf0, o2); o2 = MFMA32(vf[2][1], pf1, o2);
            o3 = MFMA32(vf[3][0], pf0, o3); o3 = MFMA32(vf[3][1], pf1, o3);
            kp += 32 * 1024; krp += 32 * 64; vp += 32;
        }
        l += __shfl_xor(l, 32);
#pragma unroll
        for (int e = 0; e < 16; ++e) {
            part[(w * 64 + e) * 64 + lane] = o0[e]; part[(w * 64 + 16 + e) * 64 + lane] = o1[e];
            part[(w * 64 + 32 + e) * 64 + lane] = o2[e]; part[(w * 64 + 48 + e) * 64 + lane] = o3[e];
        }
        ml[(w * 2) * 64 + lane] = m; ml[(w * 2 + 1) * 64 + lane] = l;
        __syncthreads();
        float M = -1e30f;
#pragma unroll
        for (int ww = 0; ww < 8; ++ww) M = fmaxf(M, ml[(ww * 2) * 64 + lane]);
        float sc[8]; float Lt = 0.f;
#pragma unroll
        for (int ww = 0; ww < 8; ++ww) { sc[ww] = __builtin_amdgcn_exp2f(ml[(ww * 2) * 64 + lane] - M); Lt += ml[(ww * 2 + 1) * 64 + lane] * sc[ww]; }
        const float inv = 1.0f / Lt;
        float ov[8];
#pragma unroll
        for (int j = 0; j < 8; ++j) {
            float acc = 0.f;
#pragma unroll
            for (int ww = 0; ww < 8; ++ww) acc += part[(ww * 64 + 8 * w + j) * 64 + lane] * sc[ww];
            ov[j] = acc * inv;
        }
        {
            const int blk = w >> 1, gq0 = 2 * (w & 1);
            bf16_t* op = MIX + (size_t)(row_q0 + q) * 2048 + 1024 + h * 128 + 32 * blk + 4 * hi;
            *(u32x2*)(op + 8 * gq0) = (u32x2){cvtpk(ov[0], ov[1]), cvtpk(ov[2], ov[3])};
            *(u32x2*)(op + 8 * (gq0 + 1)) = (u32x2){cvtpk(ov[4], ov[5]), cvtpk(ov[6], ov[7])};
        }
        __syncthreads();
    }
}
DI void assemble_sample_keys(const Args& a, const Ctx& c) {
    unsigned char* ws = a.ws;
    bf16_t* LATS = (bf16_t*)(ws + WS_LATS); bf16_t* KRS = (bf16_t*)(ws + WS_KRS);
    const float* cl = a.in[2]; const float* ck = a.in[3];
    for (int r0 = c.gw; r0 < TP; r0 += 4 * c.ngw) {
        u32x4 lw[4], kw[4];
#pragma unroll
        for (int k = 0; k < 4; ++k) {
            const int r = r0 + k * c.ngw;
            if (r < TP) {
                const float* src = cl + (size_t)r * 512 + 8 * c.lane;
                const f32x4 v0 = *(const f32x4*)src, v1 = *(const f32x4*)(src + 4);
                lw[k].x = cvtpk(v0[0], v0[1]); lw[k].y = cvtpk(v0[2], v0[3]); lw[k].z = cvtpk(v1[0], v1[1]); lw[k].w = cvtpk(v1[2], v1[3]);
                if (c.lane < 8) { const float* s2 = ck + (size_t)r * 64 + 8 * c.lane; const f32x4 k0 = *(const f32x4*)s2, k1 = *(const f32x4*)(s2 + 4);
                    kw[k].x = cvtpk(k0[0], k0[1]); kw[k].y = cvtpk(k0[2], k0[3]); kw[k].z = cvtpk(k1[0], k1[1]); kw[k].w = cvtpk(k1[2], k1[3]); }
            }
        }
#pragma unroll
        for (int k = 0; k < 4; ++k) {
            const int r = r0 + k * c.ngw;
            if (r < TP) { *(u32x4*)(LATS + (size_t)r * 512 + 8 * c.lane) = lw[k]; if (c.lane < 8) *(u32x4*)(KRS + (size_t)r * 64 + 8 * c.lane) = kw[k]; }
        }
    }
}
DI void kv_new_rows(const Args& a, const Ctx& c) {
    unsigned char* ws = a.ws;
    const bf16_t* LATN = (const bf16_t*)(ws + A_MISC) + (size_t)TP * 1280 + 512;
    const bf16_t* WUK = (const bf16_t*)(ws + WS_WUK); const bf16_t* WUV = (const bf16_t*)(ws + WS_WUV);
    bf16_t* KNN = (bf16_t*)(ws + A_KNN); bf16_t* VTN = (bf16_t*)(ws + A_VTN);
    const int lane = c.lane, il = lane & 31, hi = lane >> 5;
    for (int it = c.gw; it < 1024; it += c.ngw) {
        const bool isv = it >= 512; const int idx = it & 511;
        const int tokblk = isv ? (idx & 15) : (idx >> 5), nblk = isv ? (idx >> 4) : (idx & 31);
        const bf16_t* lp = LATN + (size_t)(32 * tokblk + il) * 1280 + 8 * hi;
        const bf16_t* wp = (isv ? WUV : WUK) + (size_t)(32 * nblk + il) * 512 + 8 * hi;
        const bf16_t* ap = isv ? wp : lp; const bf16_t* bp = isv ? lp : wp;
        f32x16 acc;
#pragma unroll
        for (int e = 0; e < 16; ++e) acc[e] = 0.f;
#pragma unroll 8
        for (int s = 0; s < 32; ++s) { const bf16x8 af = *(const bf16x8*)(ap + 16 * s), bf_ = *(const bf16x8*)(bp + 16 * s); acc = MFMA32(af, bf_, acc); }
        bf16_t* op = isv ? VTN + (size_t)(32 * nblk) * 512 + 32 * tokblk + il : KNN + (size_t)(32 * tokblk) * 1024 + 32 * nblk + il;
        const int ldo = isv ? 512 : 1024;
#pragma unroll
        for (int e = 0; e < 16; ++e) op[(size_t)crow(e, hi) * ldo] = (bf16_t)(cvtpk(acc[e], 0.f) & 0xffffu);
    }
}

DI void run_store_gemm(int gi, const Args& a, const Ctx& c) {
    unsigned char* ws = a.ws;
    pg8::Gemm g; pg8::EpiStore E; E.t1 = 1 << 30; E.t2 = 1 << 30; E.O1 = nullptr; E.ld1 = 0; E.O2 = nullptr; E.ld2 = 0;
    switch (gi) {
        case 0:
            g = pg8::Gemm{(const bf16_t*)(ws + WS_HB), (const bf16_t*)(ws + WS_WIN), DM, DM, T, NIN, DM};
            E.O0 = (bf16_t*)(ws + A_Z); E.ld0 = 1024; E.t1 = 4; E.O1 = (bf16_t*)(ws + A_XBC); E.ld1 = 1536; E.t2 = 10; E.O2 = (bf16_t*)(ws + A_MISC); E.ld2 = 1280; break;
        case 1:
            g = pg8::Gemm{(const bf16_t*)(ws + A_MISC), (const bf16_t*)(ws + WS_WUQ), 1280, 512, T, 1536, 512};
            E.O0 = (bf16_t*)(ws + A_Q); E.ld0 = 1536; break;
        case 2:
            g = pg8::Gemm{(const bf16_t*)(ws + A_MISC) + 512, (const bf16_t*)(ws + WS_WUK), 1280, 512, TP, 1024, 512};
            E.O0 = (bf16_t*)(ws + A_KN); E.ld0 = 1024; break;
        case 3:
            g = pg8::Gemm{(const bf16_t*)(ws + WS_WUV), (const bf16_t*)(ws + A_MISC) + 512, 512, 1280, 1024, TP, 512};
            E.O0 = (bf16_t*)(ws + A_VT); E.ld0 = TKS; break;
        case 4:
            g = pg8::Gemm{(const bf16_t*)(ws + WS_LATS), (const bf16_t*)(ws + WS_WUK), 512, 512, TP, 1024, 512};
            E.O0 = (bf16_t*)(ws + A_KN); E.ld0 = 1024; break;
        default:
            g = pg8::Gemm{(const bf16_t*)(ws + WS_WUV), (const bf16_t*)(ws + WS_LATS), 512, 512, 1024, TP, 512};
            E.O0 = (bf16_t*)(ws + A_VT); E.ld0 = TKS; break;
    }
    pg8::StaticOrder S; S.init(g.M, g.N, g.K, c.G, (int)blockIdx.x);
    pg8::gemm_phase<pg8::EpiStore, pg8::StaticOrder>(c.lds, g, S, E);
}
DI void run_swiglu_gemm(int which, const Args& a, const Ctx& c) {
    unsigned char* ws = a.ws;
    pg8::Gemm g{(const bf16_t*)(ws + WS_HB), (const bf16_t*)(ws + (which == 0 ? WS_WGU1 : WS_WGU2)), DM, DM, T, 2 * DFF, DM};
    pg8::EpiSwiGLU E{(bf16_t*)(ws + (which == 0 ? A_ACT : A_ACT2)), DFF};
    pg8::StaticOrder S; S.init(g.M, g.N, g.K, c.G, (int)blockIdx.x);
    pg8::gemm_phase<pg8::EpiSwiGLU, pg8::StaticOrder>(c.lds, g, S, E);
}
DI void run_res_gemm(int which, const Args& a, const Ctx& c) {
    unsigned char* ws = a.ws;
    pg8::Gemm g; pg8::EpiRes<false> E; E.xp = nullptr; E.xs = nullptr; E.hb = (const bf16_t*)(ws + WS_HB); E.alpha = ALPHA;
    int S_;
    if (which == 1) { g = pg8::Gemm{(const bf16_t*)(a.out + O_Y), (const bf16_t*)(ws + WS_WOUT), 2048, 2048, T, DM, 2048}; E.out = (float*)(ws + A_R2); E.s = 1.0f; E.part = (float*)(ws + A_PART); S_ = 8; }
    else { g = pg8::Gemm{(const bf16_t*)(ws + A_ACT2), (const bf16_t*)(ws + WS_WD2), DFF, DFF, T, DM, DFF}; E.out = a.out + O_Y; E.s = 0.5f; E.part = (float*)(ws + A_PART2); S_ = 11; }
    pg8::SplitOrder S; S.init(g.K, S_, c.G, (int)blockIdx.x);
    pg8::gemm_phase<pg8::EpiRes<false>, pg8::SplitOrder>(c.lds, g, S, E);
}

#define XB_TMO      128
#define XB_XCNT(j)  (256  + 64 * (j))
#define XB_XSUB(j)  (1280 + 64 * (j))
#define XB_XGEN(j)  (2304 + 64 * (j))
#define XB_TOP      3328
#define XB_TOPGEN   3392
#define XCD_BAR_WORDS 3456
#define XB_SPIN_CAP (1u << 18)
DI unsigned xb_ld(unsigned* p)              { return __hip_atomic_load(p, __ATOMIC_RELAXED, __HIP_MEMORY_SCOPE_AGENT); }
DI unsigned xb_add(unsigned* p, unsigned v) { return __hip_atomic_fetch_add(p, v, __ATOMIC_RELAXED, __HIP_MEMORY_SCOPE_AGENT); }
DI unsigned xb_xcc_id() { return (unsigned)__builtin_amdgcn_s_getreg((3 << 11) | 20) & 0xFu; }
#define XB_SPIN(cond, bar) do { unsigned _sp = 0; while (cond) { __builtin_amdgcn_s_sleep(1); \
    if ((++_sp & 255u) == 0u) { if (xb_ld(&(bar)[XB_TMO])) break; if (_sp > XB_SPIN_CAP) { atomicAdd(&(bar)[XB_TMO], 1u); break; } } } } while (0)
struct XcdBarrier { unsigned* bar; unsigned x; volatile LAS unsigned* st; };
DI XcdBarrier xcd_barrier_post(unsigned* bar, volatile LAS unsigned* st) {
    XcdBarrier b; b.bar = bar; b.x = xb_xcc_id(); b.st = st;
    if (threadIdx.x == 0) (void)xb_add(&bar[XB_XCNT(b.x)], 1u);
    return b;
}
DI void xcd_barrier_complete(unsigned* bar, unsigned x, unsigned& nloc, unsigned& nx) {
    const unsigned G = gridDim.x * gridDim.y * gridDim.z;
    unsigned sum, cnt, mine, sp = 0u;
    for (;;) {
        sum = 0u; cnt = 0u; mine = 0u;
#pragma unroll
        for (unsigned j = 0; j < 16; ++j) { const unsigned c = xb_ld(&bar[XB_XCNT(j)]); sum += c; cnt += (c > 0u) ? 1u : 0u; mine = (j == x) ? c : mine; }
        if (sum == G) break;
        __builtin_amdgcn_s_sleep(1);
        if ((++sp & 255u) == 0u) { if (xb_ld(&bar[XB_TMO])) break; if (sp > XB_SPIN_CAP) { atomicAdd(&bar[XB_TMO], 1u); break; } }
    }
    nloc = mine > 0u ? mine : 1u; nx = cnt > 0u ? cnt : 1u;
}
DI void xcd_barrier(const XcdBarrier& b) {
    asm volatile("s_waitcnt vmcnt(0)" ::: "memory");
    __syncthreads();
    if (threadIdx.x == 0) {
        unsigned* bar = b.bar;
        __builtin_amdgcn_s_waitcnt(0);
        unsigned nloc = b.st[0], nx = b.st[1];
        if (nloc == 0u) { xcd_barrier_complete(bar, b.x, nloc, nx); b.st[0] = nloc; b.st[1] = nx; }
        const unsigned old = xb_add(&bar[XB_XSUB(b.x)], 1u);
        const unsigned gen = old / nloc;
        if (old + 1u == (gen + 1u) * nloc) {
            __builtin_amdgcn_fence(__ATOMIC_RELEASE, "agent");
            asm volatile("s_waitcnt vmcnt(0)" ::: "memory");
            const unsigned og = xb_add(&bar[XB_TOP], 1u);
            const unsigned tg = og / nx;
            if (og + 1u == (tg + 1u) * nx) xb_add(&bar[XB_TOPGEN], 1u);
            else XB_SPIN(xb_ld(&bar[XB_TOPGEN]) == tg, bar);
            __builtin_amdgcn_fence(__ATOMIC_ACQUIRE, "agent");
            xb_add(&bar[XB_XGEN(b.x)], 1u);
            asm volatile("s_waitcnt vmcnt(0)" ::: "memory");
        } else {
            XB_SPIN(xb_ld(&bar[XB_XGEN(b.x)]) == gen, bar);
            __builtin_amdgcn_fence(__ATOMIC_ACQUIRE, "agent");
            asm volatile("s_waitcnt vmcnt(0)" ::: "memory");
        }
    }
    __syncthreads();
}

constexpr int NPHASE = 18;
__global__ void __launch_bounds__(512, 2) fwd_kernel(Args a) {
    extern __shared__ __attribute__((aligned(16))) unsigned char lds_raw[];
    Ctx c;
    c.lds = (LAS unsigned char*)lds_raw;
    c.tid = threadIdx.x; c.lane = c.tid & 63; c.wave = __builtin_amdgcn_readfirstlane(c.tid >> 6);
    c.G = gridDim.x; c.gw = blockIdx.x * 8 + c.wave; c.ngw = c.G * 8;
    unsigned char* ws = a.ws;
    volatile LAS unsigned* lctl = (volatile LAS unsigned*)(c.lds + 131072 + 512);
    if (c.tid < 64) lctl[c.tid] = 0u;
    __syncthreads();
    XcdBarrier bar; bar.bar = (unsigned*)ws; bar.x = 0; bar.st = lctl + 8;
    if (a.coop) bar = xcd_barrier_post((unsigned*)ws, lctl + 8);
    const int lo = a.ph_lo, hi = a.ph_hi;
#define IN(k) (lo <= (k) && (k) < hi)
#define SEAM(k) do { if ((k) + 1 < hi) { if (a.coop) { if (a.pad == 0x7fffffff) cg::this_grid().sync(); xcd_barrier(bar); } else __syncthreads(); } } while (0)
    if (IN(0)) { p0_prologue(a, c); SEAM(0); }
    if (IN(1)) { run_swiglu_gemm(0, a, c); SEAM(1); }
    if (IN(2)) {
        pg8::Gemm g{(const bf16_t*)(ws + A_ACT), (const bf16_t*)(ws + WS_WD1), DFF, DFF, T, DM, DFF};
        pg8::EpiRes<true> E{a.out + O_Y, a.in[0], a.in[1], nullptr, ALPHA, 0.5f, (float*)(ws + A_PART)};
        pg8::SplitOrder S; S.init(g.K, 11, c.G, (int)blockIdx.x);
        pg8::gemm_phase<pg8::EpiRes<true>, pg8::SplitOrder>(c.lds, g, S, E);
        SEAM(2);
    }
    if (IN(3)) { ln_pass(a.out + O_Y, a.in[6], a.in[7], (bf16_t*)(ws + WS_HB), nullptr, c, (const float*)(ws + A_PART), 11, a.in[1], nullptr, 0.5f); SEAM(3); }
    if (IN(4)) { run_store_gemm(0, a, c); SEAM(4); }
    if (IN(5)) { post_proj(a, c); SEAM(5); }
    if (IN(6)) { ssd_a(a, c); SEAM(6); }
    if (IN(7)) { ssd_scan(a, c); SEAM(7); }
    if (IN(8)) { ssd_c(a, c); SEAM(8); }
    if (IN(9)) { for (int gi = 1; gi <= 3; ++gi) run_store_gemm(gi, a, c); assemble_sample_keys(a, c); kv_new_rows(a, c); SEAM(9); }
    if (IN(10)) { attn_prompt(a, c); SEAM(10); }
    if (IN(11)) { for (int gi = 4; gi <= 5; ++gi) run_store_gemm(gi, a, c); SEAM(11); }
    if (IN(12)) { attn_sample(a, c); SEAM(12); }
    if (IN(13)) { run_res_gemm(1, a, c); SEAM(13); }
    if (IN(14)) { ln_pass((const float*)(ws + A_R2), a.in[23], a.in[24], (bf16_t*)(ws + WS_HB), nullptr, c, (const float*)(ws + A_PART), 8, nullptr, (const bf16_t*)(ws + WS_HB), 1.0f); SEAM(14); }
    if (IN(15)) { run_swiglu_gemm(1, a, c); SEAM(15); }
    if (IN(16)) { run_res_gemm(2, a, c); SEAM(16); }
    if (IN(17)) { ln_pass(a.out + O_Y, a.in[28], a.in[29], nullptr, a.out + O_Y, c, (const float*)(ws + A_PART2), 11, nullptr, (const bf16_t*)(ws + WS_HB), 0.5f); }
#undef IN
#undef SEAM
}

#ifndef N_LAUNCH_MODE
#define N_LAUNCH_MODE 0
#endif
extern "C" void kernel_launch(void* const* d_in, const int* in_sizes, int n_in, void* d_out, int out_size, void* d_ws, size_t ws_size, hipStream_t stream) {
    static int grid = 0;
    if (grid == 0) {
        int dev = 0, cus = 0, per_cu = 0;
        if (hipGetDevice(&dev) != hipSuccess || hipDeviceGetAttribute(&cus, hipDeviceAttributeMultiprocessorCount, dev) != hipSuccess) { fprintf(stderr, "kernel_launch: device query failed\n"); grid = -1; return; }
        if (hipFuncSetAttribute((const void*)fwd_kernel, hipFuncAttributeMaxDynamicSharedMemorySize, LDS_BYTES) != hipSuccess) { fprintf(stderr, "kernel_launch: hipFuncSetAttribute failed\n"); grid = -1; return; }
        if (hipOccupancyMaxActiveBlocksPerMultiprocessor(&per_cu, (const void*)fwd_kernel, 512, LDS_BYTES) != hipSuccess || per_cu < 1) { fprintf(stderr, "kernel_launch: occupancy query says %d\n", per_cu); per_cu = 1; }
        (void)hipGetLastError();
        grid = cus;
        if (n_in != 30 || ws_size < 256 * MiB) fprintf(stderr, "kernel_launch: unexpected n_in %d / ws %zu\n", n_in, ws_size);
    }
    if (grid < 0) return;
    Args a{};
    for (int i = 0; i < 30; ++i) a.in[i] = (const float*)d_in[i];
    a.out = (float*)d_out; a.ws = (unsigned char*)d_ws;
    for (int i = 0; i < 32; ++i) a.inv_freq[i] = powf(10000.0f, -(float)(2 * i) / 64.0f);
    a.pad = 0;
    if (hipMemsetAsync(d_ws, 0, 65536, stream) != hipSuccess) { fprintf(stderr, "kernel_launch: memset failed\n"); return; }
#if N_LAUNCH_MODE == 0
    a.ph_lo = 0; a.ph_hi = NPHASE; a.coop = 1;
    void* params[] = {&a};
    hipError_t e = hipLaunchCooperativeKernel((const void*)fwd_kernel, dim3(grid), dim3(512), params, LDS_BYTES, stream);
    if (e != hipSuccess) fprintf(stderr, "kernel_launch: cooperative launch failed: %s (grid %d)\n", hipGetErrorString(e), grid);
#else
    for (int ph = 0; ph < NPHASE; ++ph) {
        a.ph_lo = ph; a.ph_hi = ph + 1; a.coop = 0;
        hipLaunchKernelGGL(fwd_kernel, dim3(grid), dim3(512), LDS_BYTES, stream, a);
    }
#endif
}
```

```cpp
#include <hip/hip_runtime.h>
#include <hip/hip_cooperative_groups.h>
#include <cstdio>
#include <cstdint>
#include <cmath>
namespace cg = cooperative_groups;

#define LAS __attribute__((address_space(3)))
typedef unsigned short bf16_t;
typedef short bf16x8 __attribute__((ext_vector_type(8)));
typedef float f32x4 __attribute__((ext_vector_type(4)));
typedef float f32x8 __attribute__((ext_vector_type(8)));
typedef float f32x16 __attribute__((ext_vector_type(16)));
typedef unsigned u32x4 __attribute__((ext_vector_type(4)));
typedef unsigned u32x2 __attribute__((ext_vector_type(2)));
typedef float f32x2_t __attribute__((ext_vector_type(2)));
typedef __bf16 bf16x2_t __attribute__((ext_vector_type(2)));

#define DI __device__ __forceinline__
DI unsigned cvtpk(float lo, float hi) { f32x2_t v = {lo, hi}; bf16x2_t b = __builtin_convertvector(v, bf16x2_t); return __builtin_bit_cast(unsigned, b); }
DI float bflo(unsigned w) { return __uint_as_float(w << 16); }
DI float bfhi(unsigned w) { return __uint_as_float(w & 0xffff0000u); }
DI float bf2f(bf16_t b) { return __uint_as_float((unsigned)b << 16); }
DI f32x8 unpack8(u32x4 w) { f32x8 f; f[0] = bflo(w.x); f[1] = bfhi(w.x); f[2] = bflo(w.y); f[3] = bfhi(w.y); f[4] = bflo(w.z); f[5] = bfhi(w.z); f[6] = bflo(w.w); f[7] = bfhi(w.w); return f; }
DI u32x4 pack8(f32x8 f) { u32x4 w; w.x = cvtpk(f[0], f[1]); w.y = cvtpk(f[2], f[3]); w.z = cvtpk(f[4], f[5]); w.w = cvtpk(f[6], f[7]); return w; }
DI float fast_exp(float x) { return __builtin_amdgcn_exp2f(x * 1.4426950408889634f); }
DI float silu_f(float x) { return x * __builtin_amdgcn_rcpf(1.0f + fast_exp(-x)); }
DI float wave_sum(float v) {
#pragma unroll
    for (int o = 1; o < 64; o <<= 1) v += __shfl_xor(v, o);
    return v;
}
DI int crow(int r, int hi) { return (r & 3) + 8 * (r >> 2) + 4 * hi; }
#define MFMA32(a, b, c) __builtin_amdgcn_mfma_f32_32x32x16_bf16((a), (b), (c), 0, 0, 0)

constexpr int DM = 1024, TP = 16384, TS = 512, T = TP + TS;
constexpr int DFF = 2816, NIN = 3840;
constexpr int TKS = 16896;
constexpr float ALPHA = 1.189207115002721f, EPS = 1e-5f;
constexpr size_t O_Y = 0, O_LATP = 17301504, O_KRP = 25690112, O_CONVP = 26738688, O_SSMP = 26775552,
                 O_LATS = 27824128, O_KRS = 28086272, O_CONVS = 28119040, O_SSMS = 28192768;
constexpr size_t MiB = 1u << 20;
constexpr size_t WS_ROPE = 1 * MiB;
constexpr size_t WS_WGU1 = 2 * MiB, WS_WD1 = 13 * MiB, WS_WIN = 13 * MiB + 5767168, WS_WUQ = 26 * MiB, WS_WUK = 27 * MiB + 524288,
                 WS_WUV = 28 * MiB + 524288, WS_WOUT = 29 * MiB + 524288, WS_WGU2 = 33 * MiB + 524288, WS_WD2 = 44 * MiB + 524288;
constexpr size_t WS_HB = 50 * MiB;
constexpr size_t WS_A = 83 * MiB;
constexpr size_t WS_LATS = 2 * MiB, WS_KRS = 18 * MiB + 524288;
constexpr size_t A_ACT = WS_A, A_Z = WS_A, A_MISC = WS_A + 33 * MiB, A_BC = WS_A + 74 * MiB + 262144, A_DT = WS_A + 90 * MiB + 786432,
                 A_XBC = WS_A + 92 * MiB, A_ST = WS_A + 92 * MiB, A_DEC = WS_A + 160 * MiB,
                 A_KN = WS_A, A_Q = WS_A + 74 * MiB + 262144, A_VT = WS_A + 123 * MiB + 786432,
                 A_R2 = WS_A, A_ACT2 = WS_A + 66 * MiB, A_PART = WS_A + 100 * MiB, A_PART2 = WS_A;
constexpr int LDS_BYTES = 147456;

namespace pg8 {
constexpr int BM = 256, BK = 64, HALF = 128, HTB = HALF * BK * 2, STAGE_BYTES = 8 * HTB, NXCD = 8, WGM = 8;
__host__ __device__ __forceinline__ int lds_byte(int r, int c) { const int st = (r >> 4) * 2 + (c >> 5), rr = r & 15, cc = c & 31, ob = rr * 64 + cc * 2; return st * 1024 + (ob ^ (((ob >> 9) & 1) << 5)); }
__host__ __device__ __forceinline__ void stage_rc(int b, int& R, int& C) { const int st = b / 1024, sb = b % 1024, swz = sb ^ (((sb >> 9) & 1) << 5); R = (st >> 1) * 16 + swz / 64; C = (st & 1) * 32 + (swz % 64) / 2; }
__host__ __device__ __forceinline__ int perm32(int rho) { const int n = rho >> 4, i = rho & 15; return 8 * (i >> 2) + 4 * n + (i & 3); }
struct Unit { int pm, pn, k0, nt, ks; };
struct Gemm { const bf16_t* A; const bf16_t* Bt; int lda, ldb, M, N, K; };
struct StaticOrder {
    int nM, nN, nwg, G, c, ntf;
    __host__ __device__ void init(int M, int N, int K, int G_, int c_) { nM = M / BM; nN = N / BM; nwg = nM * nN; G = G_; c = c_; ntf = K / BK; }
    __host__ __device__ bool next(int i, Unit& u) const {
        const long L = (long)i * G + c; if (L >= nwg) return false;
        u.k0 = 0; u.nt = ntf; u.ks = -1;
        int wgid = (int)L; { const int q = nwg / NXCD, r = nwg % NXCD, xcd = wgid % NXCD, off = wgid / NXCD; wgid = (xcd < r ? xcd * (q + 1) : r * (q + 1) + (xcd - r) * q) + off; }
        const int nig = WGM * nN, gid = wgid / nig, fm = gid * WGM, gsz = (nM - fm) < WGM ? (nM - fm) : WGM;
        u.pm = fm + ((wgid % nig) % gsz); u.pn = (wgid % nig) / gsz; return true;
    }
};
struct SplitOrder {
    StaticOrder so; int S, G, c;
    __host__ __device__ void init(int K, int S_, int G_, int c_) { so.init(TP, 1024, K, G_, c_); S = S_; G = G_; c = c_; }
    __host__ __device__ bool next(int i, Unit& u) const {
        const int Li = i * G + c, idx = Li - 256;
        const bool isP = Li < 256;
        if (!isP && idx >= 8 * S) return false;
        int wgid = isP ? Li : 0; { const int xcd = wgid % NXCD, off = wgid / NXCD; wgid = xcd * (256 / NXCD) + off; }
        const int nig = WGM * 4, gid = wgid / nig, fm = gid * WGM;
        const int pm_p = fm + ((wgid % nig) % WGM), pn_p = (wgid % nig) / WGM;
        const int ii = isP ? 0 : idx, ks_s = ii % S, rem = ii / S, nts = so.ntf / S;
        u.pm = isP ? pm_p : 64 + (rem >> 2); u.pn = isP ? pn_p : (rem & 3);
        u.k0 = isP ? 0 : ks_s * nts; u.nt = isP ? so.ntf : nts; u.ks = isP ? -1 : ks_s;
        return true;
    }
};

struct EpiStore {
    static constexpr bool PERM = true;
    bf16_t* O0; int ld0; int t1; bf16_t* O1; int ld1; int t2; bf16_t* O2; int ld2;
    DI void operator()(const f32x4 (&acc)[2][2][4][2], const Unit& u, int wr, int wc, int fr, int fq) const {
        bf16_t* base; int ld, colt;
        if (u.pn < t1) { base = O0; ld = ld0; colt = u.pn * BM; } else if (u.pn < t2) { base = O1; ld = ld1; colt = (u.pn - t1) * BM; } else { base = O2; ld = ld2; colt = (u.pn - t2) * BM; }
        const int row0 = u.pm * BM + wr * 64 + fr, col0 = colt + wc * 32 + 8 * fq;
#pragma unroll
        for (int ai = 0; ai < 2; ++ai)
#pragma unroll
            for (int m = 0; m < 4; ++m) { bf16_t* rowp = base + (size_t)(row0 + ai * HALF + m * 16) * ld + col0;
#pragma unroll
                for (int bj = 0; bj < 2; ++bj) { const f32x4 v0 = acc[ai][bj][m][0], v1 = acc[ai][bj][m][1];
                    u32x4 w; w.x = cvtpk(v0[0], v0[1]); w.y = cvtpk(v0[2], v0[3]); w.z = cvtpk(v1[0], v1[1]); w.w = cvtpk(v1[2], v1[3]);
                    *(u32x4*)(rowp + bj * HALF) = w; } }
    }
};
struct EpiSwiGLU {
    static constexpr bool PERM = true;
    bf16_t* O; int ldc;
    DI void operator()(const f32x4 (&acc)[2][2][4][2], const Unit& u, int wr, int wc, int fr, int fq) const {
        const int row0 = u.pm * BM + wr * 64 + fr, col0 = u.pn * HALF + wc * 32 + 8 * fq;
#pragma unroll
        for (int ai = 0; ai < 2; ++ai)
#pragma unroll
            for (int m = 0; m < 4; ++m) {
                const f32x4 g0 = acc[ai][0][m][0], g1 = acc[ai][0][m][1], u0 = acc[ai][1][m][0], u1 = acc[ai][1][m][1];
                u32x4 w;
                w.x = cvtpk(silu_f(g0[0]) * u0[0], silu_f(g0[1]) * u0[1]); w.y = cvtpk(silu_f(g0[2]) * u0[2], silu_f(g0[3]) * u0[3]);
                w.z = cvtpk(silu_f(g1[0]) * u1[0], silu_f(g1[1]) * u1[1]); w.w = cvtpk(silu_f(g1[2]) * u1[2], silu_f(g1[3]) * u1[3]);
                *(u32x4*)(O + (size_t)(row0 + ai * HALF + m * 16) * ldc + col0) = w;
            }
    }
};
template <bool RESF32> struct EpiRes {
    static constexpr bool PERM = false;
    float* out; const float* xp; const float* xs; const bf16_t* hb; float alpha, s; float* part;
    DI void operator()(const f32x4 (&acc)[2][2][4][2], const Unit& u, int wr, int wc, int fr, int fq) const {
        const int col0 = u.pn * BM + wc * 32 + 4 * fq;
        float alpha = this->alpha, s = this->s; float* part = this->part; float* out = this->out;
        asm volatile("" : "+s"(alpha), "+s"(s), "+s"(part), "+s"(out));
        if (u.ks >= 0) {
            float* pb = part + (size_t)u.ks * (TS * DM);
#pragma unroll
            for (int ai = 0; ai < 2; ++ai)
#pragma unroll
                for (int m = 0; m < 4; ++m) {
                    const int row = (u.pm - 64) * BM + ai * HALF + wr * 64 + m * 16 + fr;
#pragma unroll
                    for (int bj = 0; bj < 2; ++bj)
#pragma unroll
                        for (int n = 0; n < 2; ++n) *(f32x4*)(pb + (size_t)row * DM + col0 + bj * HALF + n * 16) = acc[ai][bj][m][n];
                }
        } else {
#pragma unroll
        for (int ai = 0; ai < 2; ++ai)
#pragma unroll
            for (int mh = 0; mh < 2; ++mh) {
                f32x4 r[2][2][2];
#pragma unroll
                for (int mm = 0; mm < 2; ++mm) {
                    const int row = u.pm * BM + ai * HALF + wr * 64 + (2 * mh + mm) * 16 + fr;
#pragma unroll
                    for (int bj = 0; bj < 2; ++bj)
#pragma unroll
                        for (int n = 0; n < 2; ++n) {
                            const int col = col0 + bj * HALF + n * 16;
                            if (RESF32) { const float* xr = row < TP ? xp + (size_t)row * DM : xs + (size_t)(row - TP) * DM; r[mm][bj][n] = *(const f32x4*)(xr + col); }
                            else { const u32x2 w = *(const u32x2*)(hb + (size_t)row * DM + col); r[mm][bj][n] = (f32x4){bflo(w.x), bfhi(w.x), bflo(w.y), bfhi(w.y)}; }
                        }
                }
#pragma unroll
                for (int mm = 0; mm < 2; ++mm) {
                    const int m = 2 * mh + mm, row = u.pm * BM + ai * HALF + wr * 64 + m * 16 + fr;
#pragma unroll
                    for (int bj = 0; bj < 2; ++bj)
#pragma unroll
                        for (int n = 0; n < 2; ++n) {
                            const int col = col0 + bj * HALF + n * 16;
                            const f32x4 o = r[mm][bj][n] * alpha + acc[ai][bj][m][n] * s;
                            *(f32x4*)(out + (size_t)row * DM + col) = o;
                        }
                }
            }
        }
    }
};

template <class Epi, class Sched>
DI void gemm_phase(LAS unsigned char* lds, const Gemm g, const Sched& S, const Epi& E) {
    const int tid = threadIdx.x, wid = __builtin_amdgcn_readfirstlane(tid >> 6), lane = tid & 63, wr = wid >> 2, wc = wid & 3, fr = lane & 15, fq = lane >> 4;
    unsigned voffA[2], voffB[2];
#pragma unroll
    for (int i = 0; i < 2; ++i) { int R, C; stage_rc(tid * 16 + i * 8192, R, C); const int Rb = Epi::PERM ? ((R & ~31) + perm32(R & 31)) : R;
        voffA[i] = (unsigned)(R * g.lda + C) * 2u; voffB[i] = (unsigned)(Rb * g.ldb + C) * 2u; }
    const size_t kstep = (size_t)(BK * 2);
    const size_t hstepA = (size_t)HALF * g.lda * 2, hstepB = (size_t)HALF * g.ldb * 2;
    const size_t tstepA = 2 * hstepA, tstepB = 2 * hstepB;
    const unsigned ldsw = (unsigned)wid * 1024u;
    const int aoff = lds_byte(wr * 64 + fr, fq * 8), boff = lds_byte(wc * 32 + fr, fq * 8);
#define PG8_SA(b, h) (((b) * 2 + (h)) * HTB)
#define PG8_SB(b, h) ((4 + (b) * 2 + (h)) * HTB)
#define PG8_STAGE(bufoff, gbase, voff) do { _Pragma("unroll") for (int _i = 0; _i < 2; ++_i) \
        __builtin_amdgcn_global_load_lds((const unsigned*)((const char*)(gbase) + (voff)[_i]), (LAS unsigned*)(lds + (bufoff) + ldsw + _i * 8192), 16, 0, 0); } while (0)
#define PG8_LDA(dst, b, h) do { _Pragma("unroll") for (int m = 0; m < 4; ++m) _Pragma("unroll") for (int k = 0; k < 2; ++k) dst[m][k] = *(const LAS bf16x8*)(lds + PG8_SA(b, h) + aoff + m * 2048 + k * 1024); } while (0)
#define PG8_LDB(dst, b, h) do { _Pragma("unroll") for (int n = 0; n < 2; ++n) _Pragma("unroll") for (int k = 0; k < 2; ++k) dst[n][k] = *(const LAS bf16x8*)(lds + PG8_SB(b, h) + boff + n * 2048 + k * 1024); } while (0)
#define PG8_MMA(ai, bj, At, Bt) do { __builtin_amdgcn_s_setprio(1); _Pragma("unroll") for (int m = 0; m < 4; ++m) _Pragma("unroll") for (int n = 0; n < 2; ++n) _Pragma("unroll") for (int k = 0; k < 2; ++k) \
        acc[ai][bj][m][n] = __builtin_amdgcn_mfma_f32_16x16x32_bf16(Bt[n][k], At[m][k], acc[ai][bj][m][n], 0, 0, 0); __builtin_amdgcn_s_setprio(0); } while (0)
#define PG8_WAIT_V(n) asm volatile("s_waitcnt vmcnt(" #n ")" ::: "memory")
#define PG8_WAIT_L(n) asm volatile("s_waitcnt lgkmcnt(" #n ")" ::: "memory")
#define PG8_BAR __builtin_amdgcn_s_barrier()
#define PG8_SCHED __builtin_amdgcn_sched_barrier(0)
    Unit cur, nxt; int ui = 0;
    if (!S.next(0, cur)) return;
    f32x4 acc[2][2][4][2];
#pragma unroll
    for (int a = 0; a < 2; ++a)
#pragma unroll
        for (int b = 0; b < 2; ++b)
#pragma unroll
            for (int m = 0; m < 4; ++m)
#pragma unroll
                for (int n = 0; n < 2; ++n) acc[a][b][m][n] = (f32x4){0.f, 0.f, 0.f, 0.f};
    bf16x8 At[4][2], B0[2][2], B1[2][2];
    const char* cA = (const char*)g.A + (size_t)cur.pm * tstepA + (size_t)cur.k0 * kstep; const char* cB = (const char*)g.Bt + (size_t)cur.pn * tstepB + (size_t)cur.k0 * kstep;
    PG8_STAGE(PG8_SB(0, 0), cB, voffB); PG8_STAGE(PG8_SB(0, 1), cB + hstepB, voffB); PG8_STAGE(PG8_SA(0, 0), cA, voffA); PG8_STAGE(PG8_SA(0, 1), cA + hstepA, voffA);
    if (wr == 1) PG8_BAR;
    PG8_WAIT_V(2); PG8_BAR;
    PG8_STAGE(PG8_SB(1, 0), cB + kstep, voffB); PG8_STAGE(PG8_SA(1, 0), cA + kstep, voffA); PG8_STAGE(PG8_SB(1, 1), cB + hstepB + kstep, voffB);
    PG8_WAIT_V(6); PG8_BAR;
    for (;;) {
        const bool has_next = S.next(ui + 1, nxt);
        const char* nA = has_next ? (const char*)g.A + (size_t)nxt.pm * tstepA + (size_t)nxt.k0 * kstep : cA; const char* nB = has_next ? (const char*)g.Bt + (size_t)nxt.pn * tstepB + (size_t)nxt.k0 * kstep : cB;
        const int nt = cur.nt;
        for (int t = 0; t < nt; t += 2) {
            const bool last = (t == nt - 2);
            const char* a1 = cA + (size_t)(t + 1) * kstep;
            const char* a2 = last ? nA : cA + (size_t)(t + 2) * kstep; const char* b2 = last ? nB : cB + (size_t)(t + 2) * kstep;
            const char* a3 = a2 + kstep; const char* b3 = b2 + kstep;
            PG8_LDB(B0, 0, 0); PG8_LDB(B1, 0, 1); PG8_SCHED; PG8_LDA(At, 0, 0); PG8_STAGE(PG8_SA(1, 1), a1 + hstepA, voffA);
            PG8_WAIT_V(8); PG8_WAIT_L(0); PG8_BAR; PG8_MMA(0, 0, At, B0); PG8_MMA(0, 1, At, B1); PG8_BAR; PG8_SCHED;
            PG8_LDA(At, 0, 1); PG8_STAGE(PG8_SB(0, 0), b2, voffB); PG8_STAGE(PG8_SB(0, 1), b2 + hstepB, voffB); PG8_STAGE(PG8_SA(0, 0), a2, voffA);
            PG8_WAIT_V(8); PG8_WAIT_L(0); PG8_BAR; PG8_MMA(1, 0, At, B0); PG8_MMA(1, 1, At, B1); PG8_BAR; PG8_SCHED;
            PG8_LDB(B0, 1, 0); PG8_LDB(B1, 1, 1); PG8_SCHED; PG8_LDA(At, 1, 0); PG8_STAGE(PG8_SA(0, 1), a2 + hstepA, voffA);
            PG8_WAIT_V(8); PG8_WAIT_L(0); PG8_BAR; PG8_MMA(0, 0, At, B0); PG8_MMA(0, 1, At, B1); PG8_BAR; PG8_SCHED;
            PG8_LDA(At, 1, 1); PG8_STAGE(PG8_SB(1, 0), b3, voffB); PG8_STAGE(PG8_SB(1, 1), b3 + hstepB, voffB); PG8_STAGE(PG8_SA(1, 0), a3, voffA);
            PG8_WAIT_V(8); PG8_WAIT_L(0); PG8_BAR; PG8_MMA(1, 0, At, B0); PG8_MMA(1, 1, At, B1); PG8_BAR; PG8_SCHED;
        }
        if (wr == 0) PG8_BAR;
        E(acc, cur, wr, wc, fr, fq);
        if (!has_next) break;
#pragma unroll
        for (int a = 0; a < 2; ++a)
#pragma unroll
            for (int b = 0; b < 2; ++b)
#pragma unroll
                for (int m = 0; m < 4; ++m)
#pragma unroll
                    for (int n = 0; n < 2; ++n) acc[a][b][m][n] = (f32x4){0.f, 0.f, 0.f, 0.f};
        cur = nxt; cA = nA; cB = nB; ++ui;
        if (wr == 1) PG8_BAR;
    }
    PG8_WAIT_V(0);
    PG8_BAR;
#undef PG8_SA
#undef PG8_SB
#undef PG8_STAGE
#undef PG8_LDA
#undef PG8_LDB
#undef PG8_MMA
#undef PG8_WAIT_V
#undef PG8_WAIT_L
#undef PG8_BAR
#undef PG8_SCHED
}
}

struct Args {
    const float* in[30];
    float* out;
    unsigned char* ws;
    float inv_freq[32];
    int ph_lo, ph_hi, coop, pad;
};

struct Ctx {
    LAS unsigned char* lds;
    int tid, lane, wave, gw, ngw, G;
};

enum { WK_PLAIN = 0, WK_WIN, WK_UK, WK_UV };
DI int src_col(int kind, int n) {
    switch (kind) {
        case WK_WIN: return n < 2560 ? n : (n < 3648 ? n + 16 : (n < 3664 ? n - 1088 : -1));
        case WK_UK: return (n >> 7) * 256 + (n & 127);
        case WK_UV: return (n >> 7) * 256 + 128 + (n & 127);
        default: return n;
    }
}
DI void tr_item(const float* W, int Nsrc, int sc, bf16_t* WT, int ldt, int n0, int k0, LAS float* scr, int lane) {
    float tv[32];
#pragma unroll
    for (int i = 0; i < 32; ++i) { const int kk = 2 * i + (lane >> 5); tv[i] = sc >= 0 ? W[(size_t)(k0 + kk) * Nsrc + sc] : 0.f; }
#pragma unroll
    for (int i = 0; i < 32; ++i) { const int kk = 2 * i + (lane >> 5); scr[kk * 33 + (lane & 31)] = tv[i]; }
    asm volatile("s_waitcnt lgkmcnt(0)" ::: "memory");
    const int c = lane & 7;
#pragma unroll
    for (int j = 0; j < 4; ++j) { const int n = (lane >> 3) + 8 * j; const LAS float* s = scr + (8 * c) * 33 + n;
        u32x4 o; o.x = cvtpk(s[0 * 33], s[1 * 33]); o.y = cvtpk(s[2 * 33], s[3 * 33]); o.z = cvtpk(s[4 * 33], s[5 * 33]); o.w = cvtpk(s[6 * 33], s[7 * 33]);
        *(u32x4*)(WT + (size_t)(n0 + n) * ldt + k0 + 8 * c) = o; }
    asm volatile("s_waitcnt lgkmcnt(0)" ::: "memory");
}
DI void tr_matrix_item(int r, const float* W, int Nsrc, int K, int Nd, int kind, bf16_t* WT, LAS float* scr, int lane) {
    const int nblk = Nd / 32, kb = r / nblk, nb = r % nblk, n0 = 32 * nb;
    const int sc = src_col(kind, n0 + (lane & 31));
    tr_item(W, Nsrc, sc, WT, K, n0, 64 * kb, scr, lane);
}
DI void tr_gu_item(int r, const float* Wg, const float* Wu, bf16_t* WT, LAS float* scr, int lane) {
    const int nblk = 5632 / 32, kb = r / nblk, nb = r % nblk, n0 = 32 * nb;
    const int tile = n0 >> 8, within = n0 & 255;
    const float* W = within < 128 ? Wg : Wu;
    const int sc = tile * 128 + (within & 127) + (lane & 31);
    tr_item(W, DFF, sc, WT, DM, n0, 64 * kb, scr, lane);
}
DI void p0_prologue(const Args& a, const Ctx& c) {
    LAS float* scr = (LAS float*)(c.lds + c.wave * 16384);
    unsigned char* ws = a.ws;
    constexpr int I_GU = 16 * 176, I_D = 44 * 32, I_IN = 16 * 120, I_UQ = 8 * 48, I_UK = 8 * 32, I_OUT = 32 * 32;
    constexpr int NIT = 2 * I_GU + 2 * I_D + I_IN + I_UQ + 2 * I_UK + I_OUT;
    for (int it = c.gw; it < NIT; it += c.ngw) {
        int r = it;
        if (r < I_GU) { tr_gu_item(r, a.in[8], a.in[9], (bf16_t*)(ws + WS_WGU1), scr, c.lane); continue; } r -= I_GU;
        if (r < I_GU) { tr_gu_item(r, a.in[25], a.in[26], (bf16_t*)(ws + WS_WGU2), scr, c.lane); continue; } r -= I_GU;
        if (r < I_D) { tr_matrix_item(r, a.in[10], DM, DFF, DM, WK_PLAIN, (bf16_t*)(ws + WS_WD1), scr, c.lane); continue; } r -= I_D;
        if (r < I_D) { tr_matrix_item(r, a.in[27], DM, DFF, DM, WK_PLAIN, (bf16_t*)(ws + WS_WD2), scr, c.lane); continue; } r -= I_D;
        if (r < I_IN) { tr_matrix_item(r, a.in[11], 3664, DM, NIN, WK_WIN, (bf16_t*)(ws + WS_WIN), scr, c.lane); continue; } r -= I_IN;
        if (r < I_UQ) { tr_matrix_item(r, a.in[19], 1536, 512, 1536, WK_PLAIN, (bf16_t*)(ws + WS_WUQ), scr, c.lane); continue; } r -= I_UQ;
        if (r < I_UK) { tr_matrix_item(r, a.in[21], 2048, 512, 1024, WK_UK, (bf16_t*)(ws + WS_WUK), scr, c.lane); continue; } r -= I_UK;
        if (r < I_UK) { tr_matrix_item(r, a.in[21], 2048, 512, 1024, WK_UV, (bf16_t*)(ws + WS_WUV), scr, c.lane); continue; } r -= I_UK;
        tr_matrix_item(r, a.in[22], DM, 2048, DM, WK_PLAIN, (bf16_t*)(ws + WS_WOUT), scr, c.lane);
    }
    {
        bf16_t* xb = (bf16_t*)(ws + WS_HB);
        const int gt = blockIdx.x * 512 + c.tid, ngt = c.G * 512;
        for (int i0 = gt; i0 < T * DM / 8; i0 += 4 * ngt) {
            f32x4 va[4], vb[4];
#pragma unroll
            for (int k = 0; k < 4; ++k) { const int i = i0 + k * ngt; if (i < T * DM / 8) { const size_t e = (size_t)i * 8;
                const float* src = e < (size_t)TP * DM ? a.in[0] + e : a.in[1] + (e - (size_t)TP * DM); va[k] = *(const f32x4*)src; vb[k] = *(const f32x4*)(src + 4); } }
#pragma unroll
            for (int k = 0; k < 4; ++k) { const int i = i0 + k * ngt; if (i < T * DM / 8) {
                u32x4 w; w.x = cvtpk(va[k][0], va[k][1]); w.y = cvtpk(va[k][2], va[k][3]); w.z = cvtpk(vb[k][0], vb[k][1]); w.w = cvtpk(vb[k][2], vb[k][3]);
                *(u32x4*)(xb + (size_t)i * 8) = w; } }
        }
        float* rc = (float*)(ws + WS_ROPE); float* rs = rc + 65536;
        for (int i = gt; i < 65536; i += ngt) {
            const int pos = i >> 5, k = i & 31;
            const float ang = (float)pos * a.inv_freq[k];
            const double x = (double)ang;
            const double q = rint(x * 0.6366197723675814);
            const double r = x - q * 1.5707963267948966;
            const double r2 = r * r;
            const double sn = r * (1.0 + r2 * (-1.0 / 6 + r2 * (1.0 / 120 + r2 * (-1.0 / 5040 + r2 * (1.0 / 362880 + r2 * (-1.0 / 39916800))))));
            const double cs = 1.0 + r2 * (-0.5 + r2 * (1.0 / 24 + r2 * (-1.0 / 720 + r2 * (1.0 / 40320 + r2 * (-1.0 / 3628800 + r2 * (1.0 / 479001600))))));
            const int qi = ((int)q) & 3;
            const double cc = qi == 0 ? cs : (qi == 1 ? -sn : (qi == 2 ? -cs : sn));
            const double ss = qi == 0 ? sn : (qi == 1 ? cs : (qi == 2 ? -sn : -cs));
            rc[i] = (float)cc; rs[i] = (float)ss;
        }
    }
}

struct LnRow { f32x4 v0, v1, v2, v3; };
DI void ln_finish(LnRow& r, const f32x4 (&g)[4], const f32x4 (&b)[4]) {
    float s = (r.v0[0] + r.v0[1]) + (r.v0[2] + r.v0[3]) + (r.v1[0] + r.v1[1]) + (r.v1[2] + r.v1[3]) + (r.v2[0] + r.v2[1]) + (r.v2[2] + r.v2[3]) + (r.v3[0] + r.v3[1]) + (r.v3[2] + r.v3[3]);
    const float mean = wave_sum(s) * (1.f / DM);
    r.v0 = r.v0 - mean; r.v1 = r.v1 - mean; r.v2 = r.v2 - mean; r.v3 = r.v3 - mean;
    float q = (r.v0[0] * r.v0[0] + r.v0[1] * r.v0[1]) + (r.v0[2] * r.v0[2] + r.v0[3] * r.v0[3]) + (r.v1[0] * r.v1[0] + r.v1[1] * r.v1[1]) + (r.v1[2] * r.v1[2] + r.v1[3] * r.v1[3])
            + (r.v2[0] * r.v2[0] + r.v2[1] * r.v2[1]) + (r.v2[2] * r.v2[2] + r.v2[3] * r.v2[3]) + (r.v3[0] * r.v3[0] + r.v3[1] * r.v3[1]) + (r.v3[2] * r.v3[2] + r.v3[3] * r.v3[3]);
    const float rstd = 1.0f / sqrtf(wave_sum(q) * (1.f / DM) + EPS);
    r.v0 = r.v0 * rstd * g[0] + b[0]; r.v1 = r.v1 * rstd * g[1] + b[1]; r.v2 = r.v2 * rstd * g[2] + b[2]; r.v3 = r.v3 * rstd * g[3] + b[3];
}
DI void ln_store(const LnRow& r, int row, bf16_t* hb, float* fo, int lane) {
    if (hb) {
        bf16_t* o = hb + (size_t)row * DM + 4 * lane;
        *(u32x2*)o = (u32x2){cvtpk(r.v0[0], r.v0[1]), cvtpk(r.v0[2], r.v0[3])}; *(u32x2*)(o + 256) = (u32x2){cvtpk(r.v1[0], r.v1[1]), cvtpk(r.v1[2], r.v1[3])};
        *(u32x2*)(o + 512) = (u32x2){cvtpk(r.v2[0], r.v2[1]), cvtpk(r.v2[2], r.v2[3])}; *(u32x2*)(o + 768) = (u32x2){cvtpk(r.v3[0], r.v3[1]), cvtpk(r.v3[2], r.v3[3])};
    }
    if (fo) {
        float* o = fo + (size_t)row * DM + 4 * lane;
        *(f32x4*)o = r.v0; *(f32x4*)(o + 256) = r.v1; *(f32x4*)(o + 512) = r.v2; *(f32x4*)(o + 768) = r.v3;
    }
}
DI void ln_pass(const float* R, const float* g, const float* b, bf16_t* hb, float* fo, const Ctx& c, const float* part, int S, const float* xres, const bf16_t* hres, float sc) {
    f32x4 gg[4], bb[4];
#pragma unroll
    for (int j = 0; j < 4; ++j) { gg[j] = *(const f32x4*)(g + 256 * j + 4 * c.lane); bb[j] = *(const f32x4*)(b + 256 * j + 4 * c.lane); }
    for (int row = c.gw; row < TP; row += 2 * c.ngw) {
        const int row2 = row + c.ngw; const bool has2 = row2 < TP; const int r2 = has2 ? row2 : row;
        const float* xa = R + (size_t)row * DM + 4 * c.lane; const float* xb = R + (size_t)r2 * DM + 4 * c.lane;
        LnRow A, B;
        A.v0 = *(const f32x4*)xa; A.v1 = *(const f32x4*)(xa + 256); A.v2 = *(const f32x4*)(xa + 512); A.v3 = *(const f32x4*)(xa + 768);
        B.v0 = *(const f32x4*)xb; B.v1 = *(const f32x4*)(xb + 256); B.v2 = *(const f32x4*)(xb + 512); B.v3 = *(const f32x4*)(xb + 768);
        ln_finish(A, gg, bb); ln_finish(B, gg, bb);
        ln_store(A, row, hb, fo, c.lane);
        if (has2) ln_store(B, row2, hb, fo, c.lane);
    }
    for (int row = TP + c.gw; row < T; row += c.ngw) {
        const size_t ro = (size_t)(row - TP) * DM + 4 * c.lane;
        LnRow A; A.v0 = (f32x4){0.f, 0.f, 0.f, 0.f}; A.v1 = A.v0; A.v2 = A.v0; A.v3 = A.v0;
        for (int k = 0; k < S; ++k) { const float* pp = part + (size_t)k * (TS * DM) + ro; A.v0 += *(const f32x4*)pp; A.v1 += *(const f32x4*)(pp + 256); A.v2 += *(const f32x4*)(pp + 512); A.v3 += *(const f32x4*)(pp + 768); }
        f32x4 r0, r1, r2, r3;
        if (xres) { const float* xp = xres + ro; r0 = *(const f32x4*)xp; r1 = *(const f32x4*)(xp + 256); r2 = *(const f32x4*)(xp + 512); r3 = *(const f32x4*)(xp + 768); }
        else { const bf16_t* hp = hres + (size_t)row * DM + 4 * c.lane;
            const u32x2 w0 = *(const u32x2*)hp, w1 = *(const u32x2*)(hp + 256), w2 = *(const u32x2*)(hp + 512), w3 = *(const u32x2*)(hp + 768);
            r0 = (f32x4){bflo(w0.x), bfhi(w0.x), bflo(w0.y), bfhi(w0.y)}; r1 = (f32x4){bflo(w1.x), bfhi(w1.x), bflo(w1.y), bfhi(w1.y)};
            r2 = (f32x4){bflo(w2.x), bfhi(w2.x), bflo(w2.y), bfhi(w2.y)}; r3 = (f32x4){bflo(w3.x), bfhi(w3.x), bflo(w3.y), bfhi(w3.y)}; }
        A.v0 = r0 * ALPHA + A.v0 * sc; A.v1 = r1 * ALPHA + A.v1 * sc; A.v2 = r2 * ALPHA + A.v2 * sc; A.v3 = r3 * ALPHA + A.v3 * sc;
        ln_finish(A, gg, bb);
        ln_store(A, row, hb, fo, c.lane);
    }
}

DI void post_proj(const Args& a, const Ctx& c) {
    unsigned char* ws = a.ws;
    bf16_t* MISC = (bf16_t*)(ws + A_MISC); const bf16_t* XBC = (const bf16_t*)(ws + A_XBC);
    bf16_t* MIX = (bf16_t*)(a.out + O_Y); bf16_t* BC = (bf16_t*)(ws + A_BC); float* DT = (float*)(ws + A_DT);
    const float* rc = (const float*)(ws + WS_ROPE); const float* rs = rc + 65536;
    const float* conv_w = a.in[12]; const float* conv_b = a.in[13]; const float* dt_bias = a.in[14];
    const float* qg = a.in[18]; const float* kvg = a.in[20]; const float* sconv = a.in[4];
    const int lane = c.lane;
    const f32x4 qga = *(const f32x4*)(qg + 8 * lane), qgb = *(const f32x4*)(qg + 8 * lane + 4), kga = *(const f32x4*)(kvg + 8 * lane), kgb = *(const f32x4*)(kvg + 8 * lane + 4);
    const float dtb = dt_bias[lane & 15];
    for (int r = c.gw; r < T; r += c.ngw) {
        const bool smp = r >= TP;
        const int rr = r - TP;
        const int b = smp ? (rr >> 5) : (r >> 11), t = smp ? (rr & 31) : (r & 2047), pos = smp ? 1024 + t : t, L = smp ? 32 : 2048;
        bf16_t* mrow = MISC + (size_t)r * 1280;
        const u32x4 wq = *(const u32x4*)(mrow + 8 * lane), wkv = *(const u32x4*)(mrow + 512 + 8 * lane);
        const float x1 = bf2f(mrow[1024 + (lane & 31)]), x2 = bf2f(mrow[1056 + (lane & 31)]);
        const float draw = bf2f(mrow[1088 + (lane & 15)]);
        const float cs = rc[pos * 32 + (lane & 31)], sn = rs[pos * 32 + (lane & 31)];
        u32x4 xin[3][4];
#pragma unroll
        for (int it = 0; it < 3; ++it)
#pragma unroll
            for (int k = 0; k < 4; ++k) {
                const int tt = t - 3 + k, ch = it * 512 + 8 * lane;
                if (tt >= 0) xin[it][k] = *(const u32x4*)(XBC + (size_t)(r - 3 + k) * 1536 + ch);
                else if (smp) { const float* sp = sconv + ((size_t)b * 3 + (tt + 3)) * 1536 + ch; const f32x4 xa = *(const f32x4*)sp, xb = *(const f32x4*)(sp + 4);
                    xin[it][k].x = cvtpk(xa[0], xa[1]); xin[it][k].y = cvtpk(xa[2], xa[3]); xin[it][k].z = cvtpk(xb[0], xb[1]); xin[it][k].w = cvtpk(xb[2], xb[3]); }
                else xin[it][k] = (u32x4){0u, 0u, 0u, 0u};
            }
        f32x8 vq = unpack8(wq), vk = unpack8(wkv);
        float sq = 0.f, sk = 0.f;
#pragma unroll
        for (int j = 0; j < 8; ++j) { sq += vq[j] * vq[j]; sk += vk[j] * vk[j]; }
#pragma unroll
        for (int o = 1; o < 64; o <<= 1) { sq += __shfl_xor(sq, o); sk += __shfl_xor(sk, o); }
        const float rq = 1.0f / sqrtf(sq * (1.f / 512) + EPS), rk = 1.0f / sqrtf(sk * (1.f / 512) + EPS);
#pragma unroll
        for (int j = 0; j < 4; ++j) { vq[j] = vq[j] * rq * qga[j]; vq[4 + j] = vq[4 + j] * rq * qgb[j]; vk[j] = vk[j] * rk * kga[j]; vk[4 + j] = vk[4 + j] * rk * kgb[j]; }
        u32x4 cout[3];
        int ln = lane; asm volatile("" : "+v"(ln));
#pragma unroll
        for (int it = 0; it < 3; ++it) {
            const int ch = it * 512 + 8 * ln;
            f32x8 acc; { const f32x4 ba = *(const f32x4*)(conv_b + ch), bb = *(const f32x4*)(conv_b + ch + 4); acc = (f32x8){ba[0], ba[1], ba[2], ba[3], bb[0], bb[1], bb[2], bb[3]}; }
#pragma unroll
            for (int k = 0; k < 4; ++k) {
                const f32x8 x = unpack8(xin[it][k]);
                const f32x4 wa = *(const f32x4*)(conv_w + k * 1536 + ch), wb = *(const f32x4*)(conv_w + k * 1536 + ch + 4);
#pragma unroll
                for (int j = 0; j < 4; ++j) { acc[j] += x[j] * wa[j]; acc[4 + j] += x[4 + j] * wb[j]; }
            }
#pragma unroll
            for (int j = 0; j < 8; ++j) acc[j] = silu_f(acc[j]);
            cout[it] = pack8(acc);
        }
        *(u32x4*)(mrow + 8 * lane) = pack8(vq);
        *(u32x4*)(mrow + 512 + 8 * lane) = pack8(vk);
        {
            float* lo = smp ? a.out + O_LATS + (size_t)rr * 512 : a.out + O_LATP + (size_t)r * 512;
            *(f32x4*)(lo + 8 * lane) = (f32x4){vk[0], vk[1], vk[2], vk[3]}; *(f32x4*)(lo + 8 * lane + 4) = (f32x4){vk[4], vk[5], vk[6], vk[7]};
        }
        if (lane < 32) {
            const float o1 = x1 * cs - x2 * sn, o2 = x1 * sn + x2 * cs;
            float* ko = smp ? a.out + O_KRS + (size_t)rr * 64 : a.out + O_KRP + (size_t)r * 64;
            ko[lane] = o1; ko[32 + lane] = o2;
            mrow[1024 + lane] = (bf16_t)(cvtpk(o1, 0.f) & 0xffffu); mrow[1056 + lane] = (bf16_t)(cvtpk(o2, 0.f) & 0xffffu);
        } else if (lane < 48) {
            const float v = draw + dtb;
            DT[(size_t)r * 16 + (lane - 32)] = fmaxf(v, 0.f) + log1pf(expf(-fabsf(v)));
        }
        *(u32x4*)(MIX + (size_t)r * 2048 + 8 * lane) = cout[0];
        *(u32x4*)(MIX + (size_t)r * 2048 + 512 + 8 * lane) = cout[1];
        *(u32x4*)(BC + (size_t)r * 512 + 8 * lane) = cout[2];
        if (t >= L - 3) {
#pragma unroll
            for (int it = 0; it < 3; ++it) {
                const int ch = it * 512 + 8 * lane;
                const f32x8 cur = unpack8(xin[it][3]);
                float* co = smp ? a.out + O_CONVS + ((size_t)b * 3 + (t - (L - 3))) * 1536 + ch : a.out + O_CONVP + ((size_t)b * 3 + (t - (L - 3))) * 1536 + ch;
                *(f32x4*)co = (f32x4){cur[0], cur[1], cur[2], cur[3]}; *(f32x4*)(co + 4) = (f32x4){cur[4], cur[5], cur[6], cur[7]};
            }
        }
    }
}

constexpr int SB_ROW = 272, SX_ROW = 1040;
constexpr int L_BS = 0, L_CS = 64 * SB_ROW, L_XS = 2 * 64 * SB_ROW, L_WS = L_XS + 64 * SX_ROW;
DI void ssd_decode_item(int it, int& row0, int& nib, int& g, int& b, int& sbase, bool& smp) {
    if (it < 512) { b = it >> 6; const int ch = (it >> 1) & 31; g = it & 1; row0 = b * 2048 + 64 * ch; nib = 2; sbase = (b * 32 + ch) * 16; smp = false; }
    else { const int j = it - 512; b = j >> 1; g = j & 1; row0 = TP + 32 * b; nib = 1; sbase = 4096 + b * 16; smp = true; }
}
DI void ssd_load_chunk(const Ctx& c, const bf16_t* BC, const bf16_t* MIX, int row0, int nrows, int g, bool needC) {
    LAS unsigned char* L = c.lds;
    u32x4 vb[2], vc[2], vx[8];
#pragma unroll
    for (int k = 0; k < 2; ++k) { const int i = c.tid + 512 * k, r = i >> 4, cc = i & 15;
        if (r < nrows) { vb[k] = *(const u32x4*)(BC + (size_t)(row0 + r) * 512 + g * 128 + cc * 8); if (needC) vc[k] = *(const u32x4*)(BC + (size_t)(row0 + r) * 512 + 256 + g * 128 + cc * 8); } }
#pragma unroll
    for (int k = 0; k < 8; ++k) { const int i = c.tid + 512 * k, r = i >> 6, cc = i & 63;
        if (r < nrows) vx[k] = *(const u32x4*)(MIX + (size_t)(row0 + r) * 2048 + g * 512 + cc * 8); }
#pragma unroll
    for (int k = 0; k < 2; ++k) { const int i = c.tid + 512 * k, r = i >> 4, cc = i & 15;
        if (r < nrows) { *(LAS u32x4*)(L + L_BS + r * SB_ROW + cc * 16) = vb[k]; if (needC) *(LAS u32x4*)(L + L_CS + r * SB_ROW + cc * 16) = vc[k]; } }
#pragma unroll
    for (int k = 0; k < 8; ++k) { const int i = c.tid + 512 * k, r = i >> 6, cc = i & 63;
        if (r < nrows) *(LAS u32x4*)(L + L_XS + r * SX_ROW + cc * 16) = vx[k]; }
}
DI void ssd_a(const Args& a, const Ctx& c) {
    unsigned char* ws = a.ws;
    const bf16_t* MIX = (const bf16_t*)(a.out + O_Y); const bf16_t* BC = (const bf16_t*)(ws + A_BC); const float* DT = (const float*)(ws + A_DT);
    bf16_t* ST = (bf16_t*)(ws + A_ST); float* DEC = (float*)(ws + A_DEC);
    const float* a_log = a.in[15];
    LAS unsigned char* L = c.lds;
    LAS float* wsm = (LAS float*)(L + L_WS + c.wave * 512);
    const int lane = c.lane, r = lane & 31, kg = lane >> 5, w = c.wave;
    for (int it = blockIdx.x; it < 544; it += c.G) {
        int row0, nib, g, b, sbase; bool smp;
        ssd_decode_item(it, row0, nib, g, b, sbase, smp);
        const int nj = 32 * nib, h = 8 * g + w, item = sbase + h;
        ssd_load_chunk(c, BC, MIX, row0, nj, g, false);
        const float dtv = lane < nj ? DT[(size_t)(row0 + lane) * 16 + h] : 0.f;
        const float Ah = -expf(a_log[h]);
        float acs = dtv * Ah;
#pragma unroll
        for (int d = 1; d < 64; d <<= 1) { const float tv = __shfl_up(acs, d); if (lane >= d) acs += tv; }
        const float alast = __shfl(acs, nj - 1);
        wsm[lane] = dtv * expf(alast - acs);
        if (lane == 0) DEC[item] = expf(alast);
        __syncthreads();
        f32x16 acc[2][4];
#pragma unroll
        for (int pb = 0; pb < 2; ++pb)
#pragma unroll
            for (int nb = 0; nb < 4; ++nb)
#pragma unroll
                for (int e = 0; e < 16; ++e) acc[pb][nb][e] = 0.f;
        const int ns = nj >> 4;
        for (int s = 0; s < ns; ++s) {
            const int j0 = 16 * s + 8 * kg;
            f32x8 wv;
#pragma unroll
            for (int jj = 0; jj < 8; ++jj) wv[jj] = wsm[j0 + jj];
            bf16x8 af[2];
#pragma unroll
            for (int pb = 0; pb < 2; ++pb) {
                f32x8 x;
#pragma unroll
                for (int jj = 0; jj < 8; ++jj) x[jj] = bf2f(*(const LAS bf16_t*)(L + L_XS + (j0 + jj) * SX_ROW + (w * 64 + 32 * pb + r) * 2)) * wv[jj];
                af[pb] = __builtin_bit_cast(bf16x8, pack8(x));
            }
#pragma unroll
            for (int nb = 0; nb < 4; ++nb) {
                bf16x8 bfr;
#pragma unroll
                for (int jj = 0; jj < 8; ++jj) bfr[jj] = (short)*(const LAS bf16_t*)(L + L_BS + (j0 + jj) * SB_ROW + (32 * nb + r) * 2);
                acc[0][nb] = MFMA32(af[0], bfr, acc[0][nb]);
                acc[1][nb] = MFMA32(af[1], bfr, acc[1][nb]);
            }
        }
        __syncthreads();
        LAS unsigned char* stg = L + w * 16384;
#pragma unroll
        for (int pb = 0; pb < 2; ++pb)
#pragma unroll
            for (int nb = 0; nb < 4; ++nb)
#pragma unroll
                for (int e = 0; e < 16; ++e) *(LAS bf16_t*)(stg + ((32 * pb + crow(e, kg)) * 128 + 32 * nb + r) * 2) = (bf16_t)(cvtpk(acc[pb][nb][e], 0.f) & 0xffffu);
        asm volatile("s_waitcnt lgkmcnt(0)" ::: "memory");
        bf16_t* so = ST + (size_t)item * 8192;
#pragma unroll
        for (int k = 0; k < 16; ++k) *(u32x4*)(so + (k * 64 + lane) * 8) = *(const LAS u32x4*)(stg + (k * 64 + lane) * 16);
        __syncthreads();
    }
}
DI void ssd_scan(const Args& a, const Ctx& c) {
    unsigned char* ws = a.ws;
    bf16_t* ST = (bf16_t*)(ws + A_ST); const float* DEC = (const float*)(ws + A_DEC);
    const int gt = blockIdx.x * 512 + c.tid, ngt = c.G * 512;
    for (int i = gt; i < 131072; i += ngt) {
        const int b = i >> 14, h = (i >> 10) & 15, e = (i & 1023) * 8;
        f32x8 hv = (f32x8){0.f, 0.f, 0.f, 0.f, 0.f, 0.f, 0.f, 0.f};
        for (int cb = 0; cb < 32; cb += 8) {
            u32x4 sv[8]; float dec[8];
#pragma unroll
            for (int k = 0; k < 8; ++k) { const int item = (b * 32 + cb + k) * 16 + h; sv[k] = *(const u32x4*)(ST + (size_t)item * 8192 + e); dec[k] = DEC[item]; }
#pragma unroll
            for (int k = 0; k < 8; ++k) { const int item = (b * 32 + cb + k) * 16 + h; *(u32x4*)(ST + (size_t)item * 8192 + e) = pack8(hv); hv = hv * dec[k] + unpack8(sv[k]); }
        }
        float* o = a.out + O_SSMP + (size_t)(b * 16 + h) * 8192 + e;
        *(f32x4*)o = (f32x4){hv[0], hv[1], hv[2], hv[3]}; *(f32x4*)(o + 4) = (f32x4){hv[4], hv[5], hv[6], hv[7]};
    }
    const float* h0 = a.in[5];
    for (int i = gt; i < 262144; i += ngt) {
        const int bh = i >> 10, e = (i & 1023) * 8;
        const float* hp = h0 + (size_t)bh * 8192 + e;
        const f32x4 ha = *(const f32x4*)hp, hb = *(const f32x4*)(hp + 4);
        const f32x8 sv = unpack8(*(const u32x4*)(ST + (size_t)(4096 + bh) * 8192 + e));
        const float dec = DEC[4096 + bh];
        float* o = a.out + O_SSMS + (size_t)bh * 8192 + e;
        *(f32x4*)o = (f32x4){ha[0] * dec + sv[0], ha[1] * dec + sv[1], ha[2] * dec + sv[2], ha[3] * dec + sv[3]};
        *(f32x4*)(o + 4) = (f32x4){hb[0] * dec + sv[4], hb[1] * dec + sv[5], hb[2] * dec + sv[6], hb[3] * dec + sv[7]};
    }
}
DI void ssd_c(const Args& a, const Ctx& c) {
    unsigned char* ws = a.ws;
    bf16_t* MIX = (bf16_t*)(a.out + O_Y); const bf16_t* BC = (const bf16_t*)(ws + A_BC); const float* DT = (const float*)(ws + A_DT);
    const bf16_t* ST = (const bf16_t*)(ws + A_ST); const bf16_t* Z = (const bf16_t*)(ws + A_Z);
    const float* a_log = a.in[15]; const float* d_skip = a.in[16]; const float* ng = a.in[17]; const float* h0 = a.in[5];
    LAS unsigned char* L = c.lds;
    LAS float* wacs = (LAS float*)(L + L_WS + c.wave * 512); LAS float* wdt = wacs + 64;
    LAS float* part = (LAS float*)(L + L_WS + 4096);
    const int lane = c.lane, il = lane & 31, hi = lane >> 5, w = c.wave;
    for (int it = blockIdx.x; it < 544; it += c.G) {
        int row0, nib, g, b, sbase; bool smp;
        ssd_decode_item(it, row0, nib, g, b, sbase, smp);
        const int h = 8 * g + w, nj = 32 * nib;
        ssd_load_chunk(c, BC, MIX, row0, nj, g, true);
        const float dtv = lane < nj ? DT[(size_t)(row0 + lane) * 16 + h] : 0.f;
        const float Ah = -expf(a_log[h]);
        float acs = dtv * Ah;
#pragma unroll
        for (int d = 1; d < 64; d <<= 1) { const float tv = __shfl_up(acs, d); if (lane >= d) acs += tv; }
        wacs[lane] = acs; wdt[lane] = dtv;
        __syncthreads();
        f32x16 Y[2][2];
#pragma unroll
        for (int pb = 0; pb < 2; ++pb)
#pragma unroll
            for (int ib = 0; ib < 2; ++ib)
#pragma unroll
                for (int e = 0; e < 16; ++e) Y[pb][ib][e] = 0.f;
        const LAS unsigned char* cl0 = L + L_CS + il * SB_ROW + 16 * hi;
        if (!smp) {
            const bf16_t* hp = ST + (size_t)(sbase + h) * 8192 + (size_t)il * 128 + 8 * hi;
#pragma unroll 4
            for (int s = 0; s < 8; ++s) {
                const bf16x8 af0 = *(const bf16x8*)(hp + 16 * s), af1 = *(const bf16x8*)(hp + 32 * 128 + 16 * s);
                const bf16x8 c0 = *(const LAS bf16x8*)(cl0 + 32 * s), c1 = *(const LAS bf16x8*)(cl0 + 32 * SB_ROW + 32 * s);
                Y[0][0] = MFMA32(af0, c0, Y[0][0]); Y[1][0] = MFMA32(af1, c0, Y[1][0]);
                Y[0][1] = MFMA32(af0, c1, Y[0][1]); Y[1][1] = MFMA32(af1, c1, Y[1][1]);
            }
        } else {
            const float* hp = h0 + (size_t)(sbase - 4096 + h) * 8192 + (size_t)il * 128 + 8 * hi;
#pragma unroll 2
            for (int s = 0; s < 8; ++s) {
                bf16x8 af[2];
#pragma unroll
                for (int pb = 0; pb < 2; ++pb) { const f32x4 x0 = *(const f32x4*)(hp + pb * 4096 + 16 * s), x1 = *(const f32x4*)(hp + pb * 4096 + 16 * s + 4);
                    u32x4 pk; pk.x = cvtpk(x0[0], x0[1]); pk.y = cvtpk(x0[2], x0[3]); pk.z = cvtpk(x1[0], x1[1]); pk.w = cvtpk(x1[2], x1[3]); af[pb] = __builtin_bit_cast(bf16x8, pk); }
                const bf16x8 c0 = *(const LAS bf16x8*)(cl0 + 32 * s);
                Y[0][0] = MFMA32(af[0], c0, Y[0][0]); Y[1][0] = MFMA32(af[1], c0, Y[1][0]);
            }
        }
        {
            const float ea0 = expf(wacs[il]), ea1 = expf(wacs[32 + il]);
#pragma unroll
            for (int e = 0; e < 16; ++e) { Y[0][0][e] *= ea0; Y[1][0][e] *= ea0; Y[0][1][e] *= ea1; Y[1][1][e] *= ea1; }
        }
        for (int jb = 0; jb < nib; ++jb) {
            f32x16 MT[2];
#pragma unroll
            for (int e = 0; e < 16; ++e) { MT[0][e] = 0.f; MT[1][e] = 0.f; }
            const LAS unsigned char* bl = L + L_BS + (32 * jb + il) * SB_ROW + 16 * hi;
#pragma unroll
            for (int s = 0; s < 8; ++s) {
                const bf16x8 bf_ = *(const LAS bf16x8*)(bl + 32 * s);
                if (jb == 0) { const bf16x8 c0 = *(const LAS bf16x8*)(cl0 + 32 * s); MT[0] = MFMA32(bf_, c0, MT[0]); }
                if (nib == 2) { const bf16x8 c1 = *(const LAS bf16x8*)(cl0 + 32 * SB_ROW + 32 * s); MT[1] = MFMA32(bf_, c1, MT[1]); }
            }
            const float ai0 = wacs[il], ai1 = wacs[32 + il];
#pragma unroll
            for (int e = 0; e < 16; ++e) {
                const int jl = crow(e, hi), j = 32 * jb + jl;
                const float aj = wacs[j], dj = wdt[j];
                if (jb == 0) {
                    MT[0][e] *= (jl <= il) ? expf(ai0 - aj) * dj : 0.f;
                    MT[1][e] *= expf(fminf(ai1 - aj, 0.f)) * dj;
                } else {
                    MT[1][e] *= (jl <= il) ? expf(ai1 - aj) * dj : 0.f;
                }
            }
#pragma unroll
            for (int s2 = 0; s2 < 2; ++s2) {
                u32x4 p0, p1;
                p0.x = cvtpk(MT[0][8 * s2 + 0], MT[0][8 * s2 + 1]); p0.y = cvtpk(MT[0][8 * s2 + 2], MT[0][8 * s2 + 3]); p0.z = cvtpk(MT[0][8 * s2 + 4], MT[0][8 * s2 + 5]); p0.w = cvtpk(MT[0][8 * s2 + 6], MT[0][8 * s2 + 7]);
                p1.x = cvtpk(MT[1][8 * s2 + 0], MT[1][8 * s2 + 1]); p1.y = cvtpk(MT[1][8 * s2 + 2], MT[1][8 * s2 + 3]); p1.z = cvtpk(MT[1][8 * s2 + 4], MT[1][8 * s2 + 5]); p1.w = cvtpk(MT[1][8 * s2 + 6], MT[1][8 * s2 + 7]);
                const bf16x8 pf0 = __builtin_bit_cast(bf16x8, p0), pf1 = __builtin_bit_cast(bf16x8, p1);
#pragma unroll
                for (int pb = 0; pb < 2; ++pb) {
                    bf16x8 af;
#pragma unroll
                    for (int jj = 0; jj < 8; ++jj) { const int j = 32 * jb + 16 * s2 + 8 * (jj >> 2) + 4 * hi + (jj & 3); af[jj] = (short)*(const LAS bf16_t*)(L + L_XS + j * SX_ROW + (w * 64 + 32 * pb + il) * 2); }
                    if (jb == 0) Y[pb][0] = MFMA32(af, pf0, Y[pb][0]);
                    if (nib == 2) Y[pb][1] = MFMA32(af, pf1, Y[pb][1]);
                }
            }
        }
        const float dsk = d_skip[h];
        float ssq0 = 0.f, ssq1 = 0.f;
#pragma unroll
        for (int ib = 0; ib < 2; ++ib) {
            if (ib < nib) {
                const size_t row = (size_t)(row0 + 32 * ib + il);
#pragma unroll
                for (int pb = 0; pb < 2; ++pb)
#pragma unroll
                    for (int gq = 0; gq < 4; ++gq) {
                        const int p0 = 32 * pb + 8 * gq + 4 * hi;
                        const u32x2 xw = *(const LAS u32x2*)(L + L_XS + (32 * ib + il) * SX_ROW + (w * 64 + p0) * 2), zw = *(const u32x2*)(Z + row * 1024 + h * 64 + p0);
                        const float xv[4] = {bflo(xw.x), bfhi(xw.x), bflo(xw.y), bfhi(xw.y)}, zv[4] = {bflo(zw.x), bfhi(zw.x), bflo(zw.y), bfhi(zw.y)};
#pragma unroll
                        for (int e = 0; e < 4; ++e) { float y = Y[pb][ib][4 * gq + e] + dsk * xv[e]; y *= silu_f(zv[e]); Y[pb][ib][4 * gq + e] = y; if (ib == 0) ssq0 += y * y; else ssq1 += y * y; }
                    }
            }
        }
        ssq0 += __shfl_xor(ssq0, 32); ssq1 += __shfl_xor(ssq1, 32);
        if (hi == 0) { part[w * 64 + il] = ssq0; part[w * 64 + 32 + il] = ssq1; }
        __syncthreads();
        float t0 = 0.f, t1 = 0.f;
#pragma unroll
        for (int ww = 0; ww < 8; ++ww) { t0 += part[ww * 64 + il]; t1 += part[ww * 64 + 32 + il]; }
        const float rs0 = 1.0f / sqrtf(t0 * (1.f / 512) + EPS), rs1 = 1.0f / sqrtf(t1 * (1.f / 512) + EPS);
#pragma unroll
        for (int ib = 0; ib < 2; ++ib) {
            if (ib < nib) {
                const size_t row = (size_t)(row0 + 32 * ib + il);
                const float rs = ib == 0 ? rs0 : rs1;
#pragma unroll
                for (int pb = 0; pb < 2; ++pb)
#pragma unroll
                    for (int gq = 0; gq < 4; ++gq) {
                        const int p0 = 32 * pb + 8 * gq + 4 * hi;
                        const f32x4 gn = *(const f32x4*)(ng + h * 64 + p0);
                        u32x2 o; o.x = cvtpk(Y[pb][ib][4 * gq + 0] * rs * gn[0], Y[pb][ib][4 * gq + 1] * rs * gn[1]); o.y = cvtpk(Y[pb][ib][4 * gq + 2] * rs * gn[2], Y[pb][ib][4 * gq + 3] * rs * gn[3]);
                        *(u32x2*)(MIX + row * 2048 + h * 64 + p0) = o;
                    }
            }
        }
        __syncthreads();
    }
}

DI void load_q_frags(bf16x8 (&qf)[12], const bf16_t* Qrow, int ldq, const float* rc, const float* rs, int pos0, int lane) {
    const int q = lane & 31, hi = lane >> 5;
    constexpr float SC = 0.07216878364870322f * 1.4426950408889634f;
    const bf16_t* qp = Qrow + (size_t)q * ldq + 8 * hi;
#pragma unroll
    for (int s = 0; s < 8; ++s) { f32x8 v = unpack8(*(const u32x4*)(qp + 16 * s)); v = v * SC; qf[s] = __builtin_bit_cast(bf16x8, pack8(v)); }
    const float* cp = rc + (size_t)(pos0 + q) * 32; const float* sp = rs + (size_t)(pos0 + q) * 32;
#pragma unroll
    for (int s = 0; s < 2; ++s) {
        const f32x8 x1 = unpack8(*(const u32x4*)(qp + 128 + 16 * s)), x2 = unpack8(*(const u32x4*)(qp + 160 + 16 * s));
        const int i0 = 16 * s + 8 * hi;
        f32x8 o1, o2;
#pragma unroll
        for (int jj = 0; jj < 8; ++jj) { const float cs = cp[i0 + jj], sn = sp[i0 + jj]; o1[jj] = (x1[jj] * cs - x2[jj] * sn) * SC; o2[jj] = (x1[jj] * sn + x2[jj] * cs) * SC; }
        qf[8 + s] = __builtin_bit_cast(bf16x8, pack8(o1)); qf[10 + s] = __builtin_bit_cast(bf16x8, pack8(o2));
    }
}
DI void softmax_step(f32x16& st, float& m, float& l, f32x16& o0, f32x16& o1, f32x16& o2, f32x16& o3, bf16x8& pf0, bf16x8& pf1) {
    float mx = st[0];
#pragma unroll
    for (int e = 1; e < 16; ++e) mx = fmaxf(mx, st[e]);
    mx = fmaxf(mx, __shfl_xor(mx, 32));
    const float mn = fmaxf(m, mx);
    const float alpha = __builtin_amdgcn_exp2f(m - mn);
    m = mn;
    float ps = 0.f;
#pragma unroll
    for (int e = 0; e < 16; ++e) { st[e] = __builtin_amdgcn_exp2f(st[e] - mn); ps += st[e]; }
    l = l * alpha + ps;
    o0 = o0 * alpha; o1 = o1 * alpha; o2 = o2 * alpha; o3 = o3 * alpha;
    u32x4 p0, p1;
    p0.x = cvtpk(st[0], st[1]); p0.y = cvtpk(st[2], st[3]); p0.z = cvtpk(st[4], st[5]); p0.w = cvtpk(st[6], st[7]);
    p1.x = cvtpk(st[8], st[9]); p1.y = cvtpk(st[10], st[11]); p1.z = cvtpk(st[12], st[13]); p1.w = cvtpk(st[14], st[15]);
    pf0 = __builtin_bit_cast(bf16x8, p0); pf1 = __builtin_bit_cast(bf16x8, p1);
}
DI void store_o(bf16_t* Oout, int ldo, int lane, float inv, const f32x16& o0, const f32x16& o1, const f32x16& o2, const f32x16& o3) {
    const int q = lane & 31, hi = lane >> 5;
    bf16_t* op = Oout + (size_t)q * ldo + 4 * hi;
#pragma unroll
    for (int gq = 0; gq < 4; ++gq) {
        *(u32x2*)(op + 0 + 8 * gq) = (u32x2){cvtpk(o0[4 * gq] * inv, o0[4 * gq + 1] * inv), cvtpk(o0[4 * gq + 2] * inv, o0[4 * gq + 3] * inv)};
        *(u32x2*)(op + 32 + 8 * gq) = (u32x2){cvtpk(o1[4 * gq] * inv, o1[4 * gq + 1] * inv), cvtpk(o1[4 * gq + 2] * inv, o1[4 * gq + 3] * inv)};
        *(u32x2*)(op + 64 + 8 * gq) = (u32x2){cvtpk(o2[4 * gq] * inv, o2[4 * gq + 1] * inv), cvtpk(o2[4 * gq + 2] * inv, o2[4 * gq + 3] * inv)};
        *(u32x2*)(op + 96 + 8 * gq) = (u32x2){cvtpk(o3[4 * gq] * inv, o3[4 * gq + 1] * inv), cvtpk(o3[4 * gq + 2] * inv, o3[4 * gq + 3] * inv)};
    }
}
constexpr int ATT_STG = 40960, ATT_KR = 16384, ATT_VT = 24576;
DI void attn_unit_prompt(int b, int h, int u, const Args& a, const Ctx& c) {
    unsigned char* ws = a.ws;
    const bf16_t* Q = (const bf16_t*)(ws + A_Q); const bf16_t* KN = (const bf16_t*)(ws + A_KN); const bf16_t* VT = (const bf16_t*)(ws + A_VT);
    const bf16_t* KR = (const bf16_t*)(ws + A_MISC) + 1024; bf16_t* MIX = (bf16_t*)(a.out + O_Y);
    const float* rc = (const float*)(ws + WS_ROPE); const float* rs = rc + 65536;
    const int lane = c.lane, w = c.wave, q = lane & 31, hi = lane >> 5;
    const int krow0 = b * 2048, row_q0 = krow0 + 256 * u + 32 * w;
    const int NT = 4 * u + 4, mylim = 4 * u + (w >> 1) + 1;
    LAS unsigned char* L = c.lds;
    const char* bKN = (const char*)(KN + (size_t)krow0 * 1024 + h * 128);
    const char* bKR = (const char*)(KR + (size_t)krow0 * 1280);
    const char* bVT = (const char*)(VT + (size_t)(h * 128) * TKS + krow0);
#define ATT_DMA(stage) do { LAS unsigned char* sb_ = L + (stage) * ATT_STG; int ln_ = lane; asm volatile("" : "+v"(ln_)); \
        const int r0_ = 4 * w + (ln_ >> 4), r1_ = r0_ + 32, j_ = ln_ & 15, r2_ = 8 * w + (ln_ >> 3), d1_ = r2_ + 64, j8_ = ln_ & 7; \
        __builtin_amdgcn_global_load_lds((const unsigned*)(bKN + (unsigned)(r0_ * 2048 + ((j_ ^ (r0_ & 15)) << 4))), (LAS unsigned*)(sb_ + w * 1024), 16, 0, 0); \
        __builtin_amdgcn_global_load_lds((const unsigned*)(bKN + (unsigned)(r1_ * 2048 + ((j_ ^ (r1_ & 15)) << 4))), (LAS unsigned*)(sb_ + (w + 8) * 1024), 16, 0, 0); \
        __builtin_amdgcn_global_load_lds((const unsigned*)(bKR + (unsigned)(r2_ * 2560 + ((j8_ ^ ((r2_ >> 1) & 7)) << 4))), (LAS unsigned*)(sb_ + ATT_KR + w * 1024), 16, 0, 0); \
        __builtin_amdgcn_global_load_lds((const unsigned*)(bVT + (unsigned)(r2_ * (TKS * 2) + ((j8_ ^ ((r2_ >> 1) & 7)) << 4))), (LAS unsigned*)(sb_ + ATT_VT + w * 1024), 16, 0, 0); \
        __builtin_amdgcn_global_load_lds((const unsigned*)(bVT + (unsigned)(d1_ * (TKS * 2) + ((j8_ ^ ((d1_ >> 1) & 7)) << 4))), (LAS unsigned*)(sb_ + ATT_VT + (w + 8) * 1024), 16, 0, 0); \
        bKN += 64 * 2048; bKR += 64 * 2560; bVT += 128; } while (0)
    ATT_DMA(0);
    if (NT > 1) ATT_DMA(1);
    bf16x8 qf[12];
    load_q_frags(qf, Q + (size_t)row_q0 * 1536 + h * 192, 1536, rc, rs, 256 * u + 32 * w, lane);
    f32x16 o0, o1, o2, o3;
#pragma unroll
    for (int e = 0; e < 16; ++e) { o0[e] = 0.f; o1[e] = 0.f; o2[e] = 0.f; o3[e] = 0.f; }
    float m = -1e30f, l = 0.f;
    const int pi = (q & ~12) | ((q & 4) << 1) | ((q & 8) >> 1);
    const unsigned kn_row = (unsigned)(pi * 256), kn_x0 = (unsigned)(((pi & 15) ^ hi) << 4);
    const unsigned kr_row = (unsigned)(ATT_KR + pi * 128), kr_x0 = (unsigned)((((pi >> 1) & 7) ^ hi) << 4);
    const unsigned vt_row = (unsigned)(ATT_VT + q * 128), vt_x0 = (unsigned)((((q >> 1) & 7) ^ hi) << 4);
    int stage = 0;
    for (int t = 0; t < NT; ++t) {
        if (t + 1 < NT) asm volatile("s_waitcnt vmcnt(5)" ::: "memory"); else asm volatile("s_waitcnt vmcnt(0)" ::: "memory");
        __builtin_amdgcn_s_barrier();
        asm volatile("" ::: "memory");
        if (t + 2 < NT) { const int s2 = stage >= 1 ? stage - 1 : 2; ATT_DMA(s2); }
        if (t < mylim) {
            const LAS unsigned char* S = L + stage * ATT_STG;
#pragma unroll
            for (int sub = 0; sub < 2; ++sub) {
                unsigned kn_x = kn_x0, kr_x = kr_x0, vt_x = vt_x0;
                asm volatile("" : "+v"(kn_x), "+v"(kr_x), "+v"(vt_x));
                const LAS unsigned char* kn = S + kn_row + sub * 32 * 256;
                const LAS unsigned char* kr = S + kr_row + sub * 32 * 128;
                f32x16 st;
#pragma unroll
                for (int e = 0; e < 16; ++e) st[e] = 0.f;
#pragma unroll
                for (int s = 0; s < 8; ++s) { const bf16x8 kf = *(const LAS bf16x8*)(kn + ((unsigned)(32 * s) ^ kn_x)); st = MFMA32(kf, qf[s], st); if ((s & 3) == 3) asm volatile("" ::: "memory"); }
#pragma unroll
                for (int s = 0; s < 4; ++s) { const bf16x8 kf = *(const LAS bf16x8*)(kr + ((unsigned)(32 * s) ^ kr_x)); st = MFMA32(kf, qf[8 + s], st); }
                asm volatile("" ::: "memory");
                bf16x8 pf0, pf1;
                softmax_step(st, m, l, o0, o1, o2, o3, pf0, pf1);
                asm volatile("" ::: "memory");
                const LAS unsigned char* vt = S + vt_row;
                const unsigned c0 = (unsigned)(64 * sub) ^ vt_x, c1 = (unsigned)(64 * sub + 32) ^ vt_x;
                { const bf16x8 v0 = *(const LAS bf16x8*)(vt + c0), v1 = *(const LAS bf16x8*)(vt + c1); o0 = MFMA32(v0, pf0, o0); o0 = MFMA32(v1, pf1, o0); }
                { const bf16x8 v0 = *(const LAS bf16x8*)(vt + 32 * 128 + c0), v1 = *(const LAS bf16x8*)(vt + 32 * 128 + c1); o1 = MFMA32(v0, pf0, o1); o1 = MFMA32(v1, pf1, o1); }
                { const bf16x8 v0 = *(const LAS bf16x8*)(vt + 64 * 128 + c0), v1 = *(const LAS bf16x8*)(vt + 64 * 128 + c1); o2 = MFMA32(v0, pf0, o2); o2 = MFMA32(v1, pf1, o2); }
                { const bf16x8 v0 = *(const LAS bf16x8*)(vt + 96 * 128 + c0), v1 = *(const LAS bf16x8*)(vt + 96 * 128 + c1); o3 = MFMA32(v0, pf0, o3); o3 = MFMA32(v1, pf1, o3); }
                asm volatile("" ::: "memory");
            }
        }
        stage = stage == 2 ? 0 : stage + 1;
    }
    l += __shfl_xor(l, 32);
    store_o(MIX + (size_t)row_q0 * 2048 + 1024 + h * 128, 2048, lane, 1.0f / l, o0, o1, o2, o3);
    asm volatile("s_waitcnt lgkmcnt(0)" ::: "memory");
    __builtin_amdgcn_s_barrier();
    asm volatile("" ::: "memory");
#undef ATT_DMA
}
DI void attn_prompt(const Args& a, const Ctx& c) {
    for (int p = blockIdx.x; p < 256; p += c.G) {
        const int b = p >> 5, h = (p >> 2) & 7, uu = p & 3;
#pragma unroll 1
        for (int k = 0; k < 2; ++k) attn_unit_prompt(b, h, k == 0 ? 7 - uu : uu, a, c);
    }
}
DI void attn_sample(const Args& a, const Ctx& c) {
    unsigned char* ws = a.ws;
    const bf16_t* Q = (const bf16_t*)(ws + A_Q); const bf16_t* KN = (const bf16_t*)(ws + A_KN); const bf16_t* VT = (const bf16_t*)(ws + A_VT);
    const bf16_t* KR = (const bf16_t*)(ws + WS_KRS); bf16_t* MIX = (bf16_t*)(a.out + O_Y);
    const float* rc = (const float*)(ws + WS_ROPE); const float* rs = rc + 65536;
    const int lane = c.lane, w = c.wave, q = lane & 31, hi = lane >> 5;
    LAS float* part = (LAS float*)c.lds;
    LAS float* ml = (LAS float*)(c.lds + 131072 + 1024);
    for (int it = blockIdx.x; it < 128; it += c.G) {
        const int b = it >> 3, h = it & 7;
        const int row_q0 = TP + 32 * b, krow0 = b * 1056;
        bf16x8 qf[12];
        load_q_frags(qf, Q + (size_t)row_q0 * 1536 + h * 192, 1536, rc, rs, 1024, lane);
        f32x16 o0, o1, o2, o3;
#pragma unroll
        for (int e = 0; e < 16; ++e) { o0[e] = 0.f; o1[e] = 0.f; o2[e] = 0.f; o3[e] = 0.f; }
        float m = -1e30f, l = 0.f;
        const int kt0 = (33 * w) >> 3, kt1 = (33 * (w + 1)) >> 3;
        const int pi = (q & ~12) | ((q & 4) << 1) | ((q & 8) >> 1);
        const bf16_t* kp = KN + (size_t)(krow0 + 32 * kt0 + pi) * 1024 + h * 128 + 8 * hi;
        const bf16_t* krp = KR + (size_t)(krow0 + 32 * kt0 + pi) * 64 + 8 * hi;
        const bf16_t* vp = VT + (size_t)(h * 128 + q) * TKS + krow0 + 32 * kt0 + 8 * hi;
        for (int kt = kt0; kt < kt1; ++kt) {
            bf16x8 kf[12];
#pragma unroll
            for (int s = 0; s < 8; ++s) kf[s] = *(const bf16x8*)(kp + 16 * s);
#pragma unroll
            for (int s = 0; s < 4; ++s) kf[8 + s] = *(const bf16x8*)(krp + 16 * s);
            bf16x8 vf[4][2];
#pragma unroll
            for (int blk = 0; blk < 4; ++blk) { vf[blk][0] = *(const bf16x8*)(vp + (size_t)(32 * blk) * TKS); vf[blk][1] = *(const bf16x8*)(vp + (size_t)(32 * blk) * TKS + 16); }
            f32x16 st;
#pragma unroll
            for (int e = 0; e < 16; ++e) st[e] = 0.f;
#pragma unroll
            for (int s = 0; s < 12; ++s) st = MFMA32(kf[s], qf[s], st);
            bf16x8 pf0, pf1;
            softmax_step(st, m, l, o0, o1, o2, o3, pf0, pf1);
            o0 = MFMA32(vf[0][0], pf0, o0); o0 = MFMA32(vf[0][1], pf1, o0);
            o1 = MFMA32(vf[1][0], pf0, o1); o1 = MFMA32(vf[1][1], pf1, o1);
            o2 = MFMA32(vf[2][0], pf0, o2); o2 = MFMA32(vf[2][1], pf1, o2);
            o3 = MFMA32(vf[3][0], pf0, o3); o3 = MFMA32(vf[3][1], pf1, o3);
            kp += 32 * 1024; krp += 32 * 64; vp += 32;
        }
        l += __shfl_xor(l, 32);
#pragma unroll
        for (int e = 0; e < 16; ++e) {
            part[(w * 64 + e) * 64 + lane] = o0[e]; part[(w * 64 + 16 + e) * 64 + lane] = o1[e];
            part[(w * 64 + 32 + e) * 64 + lane] = o2[e]; part[(w * 64 + 48 + e) * 64 + lane] = o3[e];
        }
        ml[(w * 2) * 64 + lane] = m; ml[(w * 2 + 1) * 64 + lane] = l;
        __syncthreads();
        float M = -1e30f;
#pragma unroll
        for (int ww = 0; ww < 8; ++ww) M = fmaxf(M, ml[(ww * 2) * 64 + lane]);
        float sc[8]; float Lt = 0.f;
#pragma unroll
        for (int ww = 0; ww < 8; ++ww) { sc[ww] = __builtin_amdgcn_exp2f(ml[(ww * 2) * 64 + lane] - M); Lt += ml[(ww * 2 + 1) * 64 + lane] * sc[ww]; }
        const float inv = 1.0f / Lt;
        float ov[8];
#pragma unroll
        for (int j = 0; j < 8; ++j) {
            float acc = 0.f;
#pragma unroll
            for (int ww = 0; ww < 8; ++ww) acc += part[(ww * 64 + 8 * w + j) * 64 + lane] * sc[ww];
            ov[j] = acc * inv;
        }
        {
            const int blk = w >> 1, gq0 = 2 * (w & 1);
            bf16_t* op = MIX + (size_t)(row_q0 + q) * 2048 + 1024 + h * 128 + 32 * blk + 4 * hi;
            *(u32x2*)(op + 8 * gq0) = (u32x2){cvtpk(ov[0], ov[1]), cvtpk(ov[2], ov[3])};
            *(u32x2*)(op + 8 * (gq0 + 1)) = (u32x2){cvtpk(ov[4], ov[5]), cvtpk(ov[6], ov[7])};
        }
        __syncthreads();
    }
}
DI void assemble_sample_keys(const Args& a, const Ctx& c) {
    unsigned char* ws = a.ws;
    const bf16_t* MISC = (const bf16_t*)(ws + A_MISC); bf16_t* LATS = (bf16_t*)(ws + WS_LATS); bf16_t* KRS = (bf16_t*)(ws + WS_KRS);
    const float* cl = a.in[2]; const float* ck = a.in[3];
    for (int r0 = c.gw; r0 < TKS; r0 += 4 * c.ngw) {
        u32x4 lw[4], kw[4];
#pragma unroll
        for (int k = 0; k < 4; ++k) {
            const int r = r0 + k * c.ngw;
            if (r < TKS) {
                const int b = r / 1056, j = r - b * 1056;
                if (j < 1024) {
                    const float* src = cl + ((size_t)b * 1024 + j) * 512 + 8 * c.lane;
                    const f32x4 v0 = *(const f32x4*)src, v1 = *(const f32x4*)(src + 4);
                    lw[k].x = cvtpk(v0[0], v0[1]); lw[k].y = cvtpk(v0[2], v0[3]); lw[k].z = cvtpk(v1[0], v1[1]); lw[k].w = cvtpk(v1[2], v1[3]);
                    if (c.lane < 8) { const float* s2 = ck + ((size_t)b * 1024 + j) * 64 + 8 * c.lane; const f32x4 k0 = *(const f32x4*)s2, k1 = *(const f32x4*)(s2 + 4);
                        kw[k].x = cvtpk(k0[0], k0[1]); kw[k].y = cvtpk(k0[2], k0[3]); kw[k].z = cvtpk(k1[0], k1[1]); kw[k].w = cvtpk(k1[2], k1[3]); }
                } else {
                    const bf16_t* mrow = MISC + (size_t)(TP + b * 32 + (j - 1024)) * 1280;
                    lw[k] = *(const u32x4*)(mrow + 512 + 8 * c.lane);
                    if (c.lane < 8) kw[k] = *(const u32x4*)(mrow + 1024 + 8 * c.lane);
                }
            }
        }
#pragma unroll
        for (int k = 0; k < 4; ++k) {
            const int r = r0 + k * c.ngw;
            if (r < TKS) { *(u32x4*)(LATS + (size_t)r * 512 + 8 * c.lane) = lw[k]; if (c.lane < 8) *(u32x4*)(KRS + (size_t)r * 64 + 8 * c.lane) = kw[k]; }
        }
    }
}

DI void run_store_gemm(int gi, const Args& a, const Ctx& c) {
    unsigned char* ws = a.ws;
    pg8::Gemm g; pg8::EpiStore E; E.t1 = 1 << 30; E.t2 = 1 << 30; E.O1 = nullptr; E.ld1 = 0; E.O2 = nullptr; E.ld2 = 0;
    switch (gi) {
        case 0:
            g = pg8::Gemm{(const bf16_t*)(ws + WS_HB), (const bf16_t*)(ws + WS_WIN), DM, DM, T, NIN, DM};
            E.O0 = (bf16_t*)(ws + A_Z); E.ld0 = 1024; E.t1 = 4; E.O1 = (bf16_t*)(ws + A_XBC); E.ld1 = 1536; E.t2 = 10; E.O2 = (bf16_t*)(ws + A_MISC); E.ld2 = 1280; break;
        case 1:
            g = pg8::Gemm{(const bf16_t*)(ws + A_MISC), (const bf16_t*)(ws + WS_WUQ), 1280, 512, T, 1536, 512};
            E.O0 = (bf16_t*)(ws + A_Q); E.ld0 = 1536; break;
        case 2:
            g = pg8::Gemm{(const bf16_t*)(ws + A_MISC) + 512, (const bf16_t*)(ws + WS_WUK), 1280, 512, TP, 1024, 512};
            E.O0 = (bf16_t*)(ws + A_KN); E.ld0 = 1024; break;
        case 3:
            g = pg8::Gemm{(const bf16_t*)(ws + WS_WUV), (const bf16_t*)(ws + A_MISC) + 512, 512, 1280, 1024, TP, 512};
            E.O0 = (bf16_t*)(ws + A_VT); E.ld0 = TKS; break;
        case 4:
            g = pg8::Gemm{(const bf16_t*)(ws + WS_LATS), (const bf16_t*)(ws + WS_WUK), 512, 512, TKS, 1024, 512};
            E.O0 = (bf16_t*)(ws + A_KN); E.ld0 = 1024; break;
        default:
            g = pg8::Gemm{(const bf16_t*)(ws + WS_WUV), (const bf16_t*)(ws + WS_LATS), 512, 512, 1024, TKS, 512};
            E.O0 = (bf16_t*)(ws + A_VT); E.ld0 = TKS; break;
    }
    pg8::StaticOrder S; S.init(g.M, g.N, g.K, c.G, (int)blockIdx.x);
    pg8::gemm_phase<pg8::EpiStore, pg8::StaticOrder>(c.lds, g, S, E);
}
DI void run_swiglu_gemm(int which, const Args& a, const Ctx& c) {
    unsigned char* ws = a.ws;
    pg8::Gemm g{(const bf16_t*)(ws + WS_HB), (const bf16_t*)(ws + (which == 0 ? WS_WGU1 : WS_WGU2)), DM, DM, T, 2 * DFF, DM};
    pg8::EpiSwiGLU E{(bf16_t*)(ws + (which == 0 ? A_ACT : A_ACT2)), DFF};
    pg8::StaticOrder S; S.init(g.M, g.N, g.K, c.G, (int)blockIdx.x);
    pg8::gemm_phase<pg8::EpiSwiGLU, pg8::StaticOrder>(c.lds, g, S, E);
}
DI void run_res_gemm(int which, const Args& a, const Ctx& c) {
    unsigned char* ws = a.ws;
    pg8::Gemm g; pg8::EpiRes<false> E; E.xp = nullptr; E.xs = nullptr; E.hb = (const bf16_t*)(ws + WS_HB); E.alpha = ALPHA;
    int S_;
    if (which == 1) { g = pg8::Gemm{(const bf16_t*)(a.out + O_Y), (const bf16_t*)(ws + WS_WOUT), 2048, 2048, T, DM, 2048}; E.out = (float*)(ws + A_R2); E.s = 1.0f; E.part = (float*)(ws + A_PART); S_ = 8; }
    else { g = pg8::Gemm{(const bf16_t*)(ws + A_ACT2), (const bf16_t*)(ws + WS_WD2), DFF, DFF, T, DM, DFF}; E.out = a.out + O_Y; E.s = 0.5f; E.part = (float*)(ws + A_PART2); S_ = 11; }
    pg8::SplitOrder S; S.init(g.K, S_, c.G, (int)blockIdx.x);
    pg8::gemm_phase<pg8::EpiRes<false>, pg8::SplitOrder>(c.lds, g, S, E);
}

#define XB_TMO      128
#define XB_XCNT(j)  (256  + 64 * (j))
#define XB_XSUB(j)  (1280 + 64 * (j))
#define XB_XGEN(j)  (2304 + 64 * (j))
#define XB_TOP      3328
#define XB_TOPGEN   3392
#define XCD_BAR_WORDS 3456
#define XB_SPIN_CAP (1u << 18)
DI unsigned xb_ld(unsigned* p)              { return __hip_atomic_load(p, __ATOMIC_RELAXED, __HIP_MEMORY_SCOPE_AGENT); }
DI unsigned xb_add(unsigned* p, unsigned v) { return __hip_atomic_fetch_add(p, v, __ATOMIC_RELAXED, __HIP_MEMORY_SCOPE_AGENT); }
DI unsigned xb_xcc_id() { return (unsigned)__builtin_amdgcn_s_getreg((3 << 11) | 20) & 0xFu; }
#define XB_SPIN(cond, bar) do { unsigned _sp = 0; while (cond) { __builtin_amdgcn_s_sleep(1); \
    if ((++_sp & 255u) == 0u) { if (xb_ld(&(bar)[XB_TMO])) break; if (_sp > XB_SPIN_CAP) { atomicAdd(&(bar)[XB_TMO], 1u); break; } } } } while (0)
struct XcdBarrier { unsigned* bar; unsigned x; volatile LAS unsigned* st; };
DI XcdBarrier xcd_barrier_post(unsigned* bar, volatile LAS unsigned* st) {
    XcdBarrier b; b.bar = bar; b.x = xb_xcc_id(); b.st = st;
    if (threadIdx.x == 0) (void)xb_add(&bar[XB_XCNT(b.x)], 1u);
    return b;
}
DI void xcd_barrier_complete(unsigned* bar, unsigned x, unsigned& nloc, unsigned& nx) {
    const unsigned G = gridDim.x * gridDim.y * gridDim.z;
    unsigned sum, cnt, mine, sp = 0u;
    for (;;) {
        sum = 0u; cnt = 0u; mine = 0u;
#pragma unroll
        for (unsigned j = 0; j < 16; ++j) { const unsigned c = xb_ld(&bar[XB_XCNT(j)]); sum += c; cnt += (c > 0u) ? 1u : 0u; mine = (j == x) ? c : mine; }
        if (sum == G) break;
        __builtin_amdgcn_s_sleep(1);
        if ((++sp & 255u) == 0u) { if (xb_ld(&bar[XB_TMO])) break; if (sp > XB_SPIN_CAP) { atomicAdd(&bar[XB_TMO], 1u); break; } }
    }
    nloc = mine > 0u ? mine : 1u; nx = cnt > 0u ? cnt : 1u;
}
DI void xcd_barrier(const XcdBarrier& b) {
    asm volatile("s_waitcnt vmcnt(0)" ::: "memory");
    __syncthreads();
    if (threadIdx.x == 0) {
        unsigned* bar = b.bar;
        __builtin_amdgcn_s_waitcnt(0);
        unsigned nloc = b.st[0], nx = b.st[1];
        if (nloc == 0u) { xcd_barrier_complete(bar, b.x, nloc, nx); b.st[0] = nloc; b.st[1] = nx; }
        const unsigned old = xb_add(&bar[XB_XSUB(b.x)], 1u);
        const unsigned gen = old / nloc;
        if (old + 1u == (gen + 1u) * nloc) {
            __builtin_amdgcn_fence(__ATOMIC_RELEASE, "agent");
            asm volatile("s_waitcnt vmcnt(0)" ::: "memory");
            const unsigned og = xb_add(&bar[XB_TOP], 1u);
            const unsigned tg = og / nx;
            if (og + 1u == (tg + 1u) * nx) xb_add(&bar[XB_TOPGEN], 1u);
            else XB_SPIN(xb_ld(&bar[XB_TOPGEN]) == tg, bar);
            __builtin_amdgcn_fence(__ATOMIC_ACQUIRE, "agent");
            xb_add(&bar[XB_XGEN(b.x)], 1u);
            asm volatile("s_waitcnt vmcnt(0)" ::: "memory");
        } else {
            XB_SPIN(xb_ld(&bar[XB_XGEN(b.x)]) == gen, bar);
            __builtin_amdgcn_fence(__ATOMIC_ACQUIRE, "agent");
            asm volatile("s_waitcnt vmcnt(0)" ::: "memory");
        }
    }
    __syncthreads();
}

constexpr int NPHASE = 18;
__global__ void __launch_bounds__(512, 2) fwd_kernel(Args a) {
    extern __shared__ __attribute__((aligned(16))) unsigned char lds_raw[];
    Ctx c;
    c.lds = (LAS unsigned char*)lds_raw;
    c.tid = threadIdx.x; c.lane = c.tid & 63; c.wave = __builtin_amdgcn_readfirstlane(c.tid >> 6);
    c.G = gridDim.x; c.gw = blockIdx.x * 8 + c.wave; c.ngw = c.G * 8;
    unsigned char* ws = a.ws;
    volatile LAS unsigned* lctl = (volatile LAS unsigned*)(c.lds + 131072 + 512);
    if (c.tid < 64) lctl[c.tid] = 0u;
    __syncthreads();
    XcdBarrier bar; bar.bar = (unsigned*)ws; bar.x = 0; bar.st = lctl + 8;
    if (a.coop) bar = xcd_barrier_post((unsigned*)ws, lctl + 8);
    const int wave_s = c.wave;
    const int lo = a.ph_lo, hi = a.ph_hi;
#define IN(k) (lo <= (k) && (k) < hi)
#define FRESH() do { int l_ = (int)__builtin_amdgcn_mbcnt_hi(~0u, __builtin_amdgcn_mbcnt_lo(~0u, 0u)); asm volatile("" : "+v"(l_)); c.lane = l_; c.wave = wave_s; c.tid = wave_s * 64 + l_; c.gw = blockIdx.x * 8 + wave_s; } while (0)
#define SEAM(k) do { if ((k) + 1 < hi) { if (a.coop) { if (a.pad == 0x7fffffff) cg::this_grid().sync(); xcd_barrier(bar); } else __syncthreads(); } } while (0)
    if (IN(0)) { FRESH(); p0_prologue(a, c); SEAM(0); }
    if (IN(1)) { FRESH(); run_swiglu_gemm(0, a, c); SEAM(1); }
    if (IN(2)) { FRESH();
        pg8::Gemm g{(const bf16_t*)(ws + A_ACT), (const bf16_t*)(ws + WS_WD1), DFF, DFF, T, DM, DFF};
        pg8::EpiRes<true> E{a.out + O_Y, a.in[0], a.in[1], nullptr, ALPHA, 0.5f, (float*)(ws + A_PART)};
        pg8::SplitOrder S; S.init(g.K, 11, c.G, (int)blockIdx.x);
        pg8::gemm_phase<pg8::EpiRes<true>, pg8::SplitOrder>(c.lds, g, S, E);
        SEAM(2);
    }
    if (IN(3)) { FRESH(); ln_pass(a.out + O_Y, a.in[6], a.in[7], (bf16_t*)(ws + WS_HB), nullptr, c, (const float*)(ws + A_PART), 11, a.in[1], nullptr, 0.5f); SEAM(3); }
    if (IN(4)) { FRESH(); run_store_gemm(0, a, c); SEAM(4); }
    if (IN(5)) { FRESH(); post_proj(a, c); SEAM(5); }
    if (IN(6)) { FRESH(); ssd_a(a, c); SEAM(6); }
    if (IN(7)) { FRESH(); ssd_scan(a, c); SEAM(7); }
    if (IN(8)) { FRESH(); ssd_c(a, c); SEAM(8); }
    if (IN(9)) { FRESH(); for (int gi = 1; gi <= 3; ++gi) run_store_gemm(gi, a, c); assemble_sample_keys(a, c); SEAM(9); }
    if (IN(10)) { FRESH(); attn_prompt(a, c); SEAM(10); }
    if (IN(11)) { FRESH(); for (int gi = 4; gi <= 5; ++gi) run_store_gemm(gi, a, c); SEAM(11); }
    if (IN(12)) { FRESH(); attn_sample(a, c); SEAM(12); }
    if (IN(13)) { FRESH(); run_res_gemm(1, a, c); SEAM(13); }
    if (IN(14)) { FRESH(); ln_pass((const float*)(ws + A_R2), a.in[23], a.in[24], (bf16_t*)(ws + WS_HB), nullptr, c, (const float*)(ws + A_PART), 8, nullptr, (const bf16_t*)(ws + WS_HB), 1.0f); SEAM(14); }
    if (IN(15)) { FRESH(); run_swiglu_gemm(1, a, c); SEAM(15); }
    if (IN(16)) { FRESH(); run_res_gemm(2, a, c); SEAM(16); }
    if (IN(17)) { FRESH(); ln_pass(a.out + O_Y, a.in[28], a.in[29], nullptr, a.out + O_Y, c, (const float*)(ws + A_PART2), 11, nullptr, (const bf16_t*)(ws + WS_HB), 0.5f); }
#undef IN
#undef SEAM
#undef FRESH
}

#ifndef N_LAUNCH_MODE
#define N_LAUNCH_MODE 0
#endif
extern "C" void kernel_launch(void* const* d_in, const int* in_sizes, int n_in, void* d_out, int out_size, void* d_ws, size_t ws_size, hipStream_t stream) {
    static int grid = 0;
    if (grid == 0) {
        int dev = 0, cus = 0, per_cu = 0;
        if (hipGetDevice(&dev) != hipSuccess || hipDeviceGetAttribute(&cus, hipDeviceAttributeMultiprocessorCount, dev) != hipSuccess) { fprintf(stderr, "kernel_launch: device query failed\n"); grid = -1; return; }
        if (hipFuncSetAttribute((const void*)fwd_kernel, hipFuncAttributeMaxDynamicSharedMemorySize, LDS_BYTES) != hipSuccess) { fprintf(stderr, "kernel_launch: hipFuncSetAttribute failed\n"); grid = -1; return; }
        if (hipOccupancyMaxActiveBlocksPerMultiprocessor(&per_cu, (const void*)fwd_kernel, 512, LDS_BYTES) != hipSuccess || per_cu < 1) { fprintf(stderr, "kernel_launch: occupancy query says %d\n", per_cu); per_cu = 1; }
        (void)hipGetLastError();
        grid = cus;
        if (n_in != 30 || ws_size < 256 * MiB) fprintf(stderr, "kernel_launch: unexpected n_in %d / ws %zu\n", n_in, ws_size);
    }
    if (grid < 0) return;
    Args a{};
    for (int i = 0; i < 30; ++i) a.in[i] = (const float*)d_in[i];
    a.out = (float*)d_out; a.ws = (unsigned char*)d_ws;
    for (int i = 0; i < 32; ++i) a.inv_freq[i] = powf(10000.0f, -(float)(2 * i) / 64.0f);
    a.pad = 0;
    if (hipMemsetAsync(d_ws, 0, 65536, stream) != hipSuccess) { fprintf(stderr, "kernel_launch: memset failed\n"); return; }
#if N_LAUNCH_MODE == 0
    a.ph_lo = 0; a.ph_hi = NPHASE; a.coop = 1;
    void* params[] = {&a};
    hipError_t e = hipLaunchCooperativeKernel((const void*)fwd_kernel, dim3(grid), dim3(512), params, LDS_BYTES, stream);
    if (e != hipSuccess) fprintf(stderr, "kernel_launch: cooperative launch failed: %s (grid %d)\n", hipGetErrorString(e), grid);
#else
    for (int ph = 0; ph < NPHASE; ++ph) {
        a.ph_lo = ph; a.ph_hi = ph + 1; a.coop = 0;
        hipLaunchKernelGGL(fwd_kernel, dim3(grid), dim3(512), LDS_BYTES, stream, a);
    }
#endif
}
```

```cpp
#include <hip/hip_runtime.h>
#include <hip/hip_cooperative_groups.h>
#include <cstdio>
#include <cstdint>
#include <cmath>
namespace cg = cooperative_groups;

#define LAS __attribute__((address_space(3)))
typedef unsigned short bf16_t;
typedef short bf16x8 __attribute__((ext_vector_type(8)));
typedef float f32x4 __attribute__((ext_vector_type(4)));
typedef float f32x8 __attribute__((ext_vector_type(8)));
typedef float f32x16 __attribute__((ext_vector_type(16)));
typedef unsigned u32x4 __attribute__((ext_vector_type(4)));
typedef unsigned u32x2 __attribute__((ext_vector_type(2)));
typedef float f32x2_t __attribute__((ext_vector_type(2)));
typedef __bf16 bf16x2_t __attribute__((ext_vector_type(2)));

#define DI __device__ __forceinline__
DI unsigned cvtpk(float lo, float hi) { f32x2_t v = {lo, hi}; bf16x2_t b = __builtin_convertvector(v, bf16x2_t); return __builtin_bit_cast(unsigned, b); }
DI float bflo(unsigned w) { return __uint_as_float(w << 16); }
DI float bfhi(unsigned w) { return __uint_as_float(w & 0xffff0000u); }
DI float bf2f(bf16_t b) { return __uint_as_float((unsigned)b << 16); }
DI f32x8 unpack8(u32x4 w) { f32x8 f; f[0] = bflo(w.x); f[1] = bfhi(w.x); f[2] = bflo(w.y); f[3] = bfhi(w.y); f[4] = bflo(w.z); f[5] = bfhi(w.z); f[6] = bflo(w.w); f[7] = bfhi(w.w); return f; }
DI u32x4 pack8(f32x8 f) { u32x4 w; w.x = cvtpk(f[0], f[1]); w.y = cvtpk(f[2], f[3]); w.z = cvtpk(f[4], f[5]); w.w = cvtpk(f[6], f[7]); return w; }
DI float fast_exp(float x) { return __builtin_amdgcn_exp2f(x * 1.4426950408889634f); }
DI float silu_f(float x) { return x * __builtin_amdgcn_rcpf(1.0f + fast_exp(-x)); }
DI float wave_sum(float v) {
#pragma unroll
    for (int o = 1; o < 64; o <<= 1) v += __shfl_xor(v, o);
    return v;
}
DI int crow(int r, int hi) { return (r & 3) + 8 * (r >> 2) + 4 * hi; }
#define MFMA32(a, b, c) __builtin_amdgcn_mfma_f32_32x32x16_bf16((a), (b), (c), 0, 0, 0)

constexpr int DM = 1024, TP = 16384, TS = 512, T = TP + TS;
constexpr int DFF = 2816, NIN = 3840;
constexpr int TKS = 16896;
constexpr float ALPHA = 1.189207115002721f, EPS = 1e-5f;
constexpr size_t O_Y = 0, O_LATP = 17301504, O_KRP = 25690112, O_CONVP = 26738688, O_SSMP = 26775552,
                 O_LATS = 27824128, O_KRS = 28086272, O_CONVS = 28119040, O_SSMS = 28192768;
constexpr size_t MiB = 1u << 20;
constexpr size_t WS_ROPE = 1 * MiB;
constexpr size_t WS_WGU1 = 2 * MiB, WS_WD1 = 13 * MiB, WS_WIN = 13 * MiB + 5767168, WS_WUQ = 26 * MiB, WS_WUK = 27 * MiB + 524288,
                 WS_WUV = 28 * MiB + 524288, WS_WOUT = 29 * MiB + 524288, WS_WGU2 = 33 * MiB + 524288, WS_WD2 = 44 * MiB + 524288;
constexpr size_t WS_HB = 50 * MiB;
constexpr size_t WS_A = 83 * MiB;
constexpr size_t WS_LATS = 2 * MiB, WS_KRS = 18 * MiB + 524288;
constexpr size_t A_ACT = WS_A, A_Z = WS_A, A_MISC = WS_A + 33 * MiB, A_BC = WS_A + 74 * MiB + 262144, A_DT = WS_A + 90 * MiB + 786432,
                 A_XBC = WS_A + 92 * MiB, A_ST = WS_A + 92 * MiB, A_DEC = WS_A + 160 * MiB,
                 A_KN = WS_A, A_Q = WS_A + 74 * MiB + 262144, A_VT = WS_A + 123 * MiB + 786432,
                 A_R2 = WS_A, A_ACT2 = WS_A + 66 * MiB, A_PART = WS_A + 100 * MiB, A_PART2 = WS_A;
constexpr int LDS_BYTES = 147456;

namespace pg8 {
constexpr int BM = 256, BK = 64, HALF = 128, HTB = HALF * BK * 2, STAGE_BYTES = 8 * HTB, NXCD = 8, WGM = 8;
__host__ __device__ __forceinline__ int lds_byte(int r, int c) { const int st = (r >> 4) * 2 + (c >> 5), rr = r & 15, cc = c & 31, ob = rr * 64 + cc * 2; return st * 1024 + (ob ^ (((ob >> 9) & 1) << 5)); }
__host__ __device__ __forceinline__ void stage_rc(int b, int& R, int& C) { const int st = b / 1024, sb = b % 1024, swz = sb ^ (((sb >> 9) & 1) << 5); R = (st >> 1) * 16 + swz / 64; C = (st & 1) * 32 + (swz % 64) / 2; }
__host__ __device__ __forceinline__ int perm32(int rho) { const int n = rho >> 4, i = rho & 15; return 8 * (i >> 2) + 4 * n + (i & 3); }
struct Unit { int pm, pn, k0, nt, ks, sel; };
struct Gemm { const bf16_t* A; const bf16_t* Bt; int lda, ldb, M, N, K; const bf16_t* A2; const bf16_t* Bt2; };
struct StaticOrder {
    int nM, nN, nwg, G, c, ntf;
    __host__ __device__ void init(int M, int N, int K, int G_, int c_) { nM = M / BM; nN = N / BM; nwg = nM * nN; G = G_; c = c_; ntf = K / BK; }
    __host__ __device__ bool next(int i, Unit& u) const {
        const long L = (long)i * G + c; if (L >= nwg) return false;
        u.k0 = 0; u.nt = ntf; u.ks = -1; u.sel = 0;
        int wgid = (int)L; { const int q = nwg / NXCD, r = nwg % NXCD, xcd = wgid % NXCD, off = wgid / NXCD; wgid = (xcd < r ? xcd * (q + 1) : r * (q + 1) + (xcd - r) * q) + off; }
        const int nig = WGM * nN, gid = wgid / nig, fm = gid * WGM, gsz = (nM - fm) < WGM ? (nM - fm) : WGM;
        u.pm = fm + ((wgid % nig) % gsz); u.pn = (wgid % nig) / gsz; return true;
    }
};
struct DualOrder {
    int n0, n1, G, c, ntf;
    __host__ __device__ void init(int n0_, int n1_, int K, int G_, int c_) { n0 = n0_; n1 = n1_; G = G_; c = c_; ntf = K / BK; }
    __host__ __device__ bool next(int i, Unit& u) const {
        const int Li = i * G + c; if (Li >= n0 + n1) return false;
        const bool first = Li < n0; const int idx = first ? Li : Li - n0;
        u.pm = first ? (idx >> 2) : (idx & 3); u.pn = first ? (idx & 3) : (idx >> 2);
        u.k0 = 0; u.nt = ntf; u.ks = -1; u.sel = first ? 0 : 1; return true;
    }
};
struct SplitOrder {
    StaticOrder so; int S, G, c;
    __host__ __device__ void init(int K, int S_, int G_, int c_) { so.init(TP, 1024, K, G_, c_); S = S_; G = G_; c = c_; }
    __host__ __device__ bool next(int i, Unit& u) const {
        const int Li = i * G + c, idx = Li - 256;
        const bool isP = Li < 256;
        if (!isP && idx >= 8 * S) return false;
        int wgid = isP ? Li : 0; { const int xcd = wgid % NXCD, off = wgid / NXCD; wgid = xcd * (256 / NXCD) + off; }
        const int nig = WGM * 4, gid = wgid / nig, fm = gid * WGM;
        const int pm_p = fm + ((wgid % nig) % WGM), pn_p = (wgid % nig) / WGM;
        const int ii = isP ? 0 : idx, ks_s = ii % S, rem = ii / S, nts = so.ntf / S;
        u.pm = isP ? pm_p : 64 + (rem >> 2); u.pn = isP ? pn_p : (rem & 3);
        u.k0 = isP ? 0 : ks_s * nts; u.nt = isP ? so.ntf : nts; u.ks = isP ? -1 : ks_s; u.sel = 0;
        return true;
    }
};

struct EpiStore {
    static constexpr bool PERM = true;
    bf16_t* O0; int ld0; int t1; bf16_t* O1; int ld1; int t2; bf16_t* O2; int ld2;
    DI void operator()(const f32x4 (&acc)[2][2][4][2], const Unit& u, int wr, int wc, int fr, int fq) const {
        bf16_t* base; int ld, colt;
        if (u.sel) { base = O1; ld = ld1; colt = u.pn * BM; } else if (u.pn < t1) { base = O0; ld = ld0; colt = u.pn * BM; } else if (u.pn < t2) { base = O1; ld = ld1; colt = (u.pn - t1) * BM; } else { base = O2; ld = ld2; colt = (u.pn - t2) * BM; }
        const int row0 = u.pm * BM + wr * 64 + fr, col0 = colt + wc * 32 + 8 * fq;
#pragma unroll
        for (int ai = 0; ai < 2; ++ai)
#pragma unroll
            for (int m = 0; m < 4; ++m) { bf16_t* rowp = base + (size_t)(row0 + ai * HALF + m * 16) * ld + col0;
#pragma unroll
                for (int bj = 0; bj < 2; ++bj) { const f32x4 v0 = acc[ai][bj][m][0], v1 = acc[ai][bj][m][1];
                    u32x4 w; w.x = cvtpk(v0[0], v0[1]); w.y = cvtpk(v0[2], v0[3]); w.z = cvtpk(v1[0], v1[1]); w.w = cvtpk(v1[2], v1[3]);
                    *(u32x4*)(rowp + bj * HALF) = w; } }
    }
};
struct EpiSwiGLU {
    static constexpr bool PERM = true;
    bf16_t* O; int ldc;
    DI void operator()(const f32x4 (&acc)[2][2][4][2], const Unit& u, int wr, int wc, int fr, int fq) const {
        const int row0 = u.pm * BM + wr * 64 + fr, col0 = u.pn * HALF + wc * 32 + 8 * fq;
#pragma unroll
        for (int ai = 0; ai < 2; ++ai)
#pragma unroll
            for (int m = 0; m < 4; ++m) {
                const f32x4 g0 = acc[ai][0][m][0], g1 = acc[ai][0][m][1], u0 = acc[ai][1][m][0], u1 = acc[ai][1][m][1];
                u32x4 w;
                w.x = cvtpk(silu_f(g0[0]) * u0[0], silu_f(g0[1]) * u0[1]); w.y = cvtpk(silu_f(g0[2]) * u0[2], silu_f(g0[3]) * u0[3]);
                w.z = cvtpk(silu_f(g1[0]) * u1[0], silu_f(g1[1]) * u1[1]); w.w = cvtpk(silu_f(g1[2]) * u1[2], silu_f(g1[3]) * u1[3]);
                *(u32x4*)(O + (size_t)(row0 + ai * HALF + m * 16) * ldc + col0) = w;
            }
    }
};
template <bool RESF32> struct EpiRes {
    static constexpr bool PERM = false;
    float* out; const float* xp; const float* xs; const bf16_t* hb; float alpha, s; float* part;
    DI void operator()(const f32x4 (&acc)[2][2][4][2], const Unit& u, int wr, int wc, int fr, int fq) const {
        const int col0 = u.pn * BM + wc * 32 + 4 * fq;
        float alpha = this->alpha, s = this->s; float* part = this->part; float* out = this->out;
        asm volatile("" : "+s"(alpha), "+s"(s), "+s"(part), "+s"(out));
        if (u.ks >= 0) {
            float* pb = part + (size_t)u.ks * (TS * DM);
#pragma unroll
            for (int ai = 0; ai < 2; ++ai)
#pragma unroll
                for (int m = 0; m < 4; ++m) {
                    const int row = (u.pm - 64) * BM + ai * HALF + wr * 64 + m * 16 + fr;
#pragma unroll
                    for (int bj = 0; bj < 2; ++bj)
#pragma unroll
                        for (int n = 0; n < 2; ++n) *(f32x4*)(pb + (size_t)row * DM + col0 + bj * HALF + n * 16) = acc[ai][bj][m][n];
                }
        } else {
#pragma unroll
        for (int ai = 0; ai < 2; ++ai)
#pragma unroll
            for (int mh = 0; mh < 2; ++mh) {
                f32x4 r[2][2][2];
#pragma unroll
                for (int mm = 0; mm < 2; ++mm) {
                    const int row = u.pm * BM + ai * HALF + wr * 64 + (2 * mh + mm) * 16 + fr;
#pragma unroll
                    for (int bj = 0; bj < 2; ++bj)
#pragma unroll
                        for (int n = 0; n < 2; ++n) {
                            const int col = col0 + bj * HALF + n * 16;
                            if (RESF32) { const float* xr = row < TP ? xp + (size_t)row * DM : xs + (size_t)(row - TP) * DM; r[mm][bj][n] = *(const f32x4*)(xr + col); }
                            else { const u32x2 w = *(const u32x2*)(hb + (size_t)row * DM + col); r[mm][bj][n] = (f32x4){bflo(w.x), bfhi(w.x), bflo(w.y), bfhi(w.y)}; }
                        }
                }
#pragma unroll
                for (int mm = 0; mm < 2; ++mm) {
                    const int m = 2 * mh + mm, row = u.pm * BM + ai * HALF + wr * 64 + m * 16 + fr;
#pragma unroll
                    for (int bj = 0; bj < 2; ++bj)
#pragma unroll
                        for (int n = 0; n < 2; ++n) {
                            const int col = col0 + bj * HALF + n * 16;
                            const f32x4 o = r[mm][bj][n] * alpha + acc[ai][bj][m][n] * s;
                            *(f32x4*)(out + (size_t)row * DM + col) = o;
                        }
                }
            }
        }
    }
};

template <class Epi, class Sched>
DI void gemm_phase(LAS unsigned char* lds, const Gemm g, const Sched& S, const Epi& E) {
    const int tid = threadIdx.x, wid = __builtin_amdgcn_readfirstlane(tid >> 6), lane = tid & 63, wr = wid >> 2, wc = wid & 3, fr = lane & 15, fq = lane >> 4;
    unsigned voffA[2], voffB[2];
#pragma unroll
    for (int i = 0; i < 2; ++i) { int R, C; stage_rc(tid * 16 + i * 8192, R, C); const int Rb = Epi::PERM ? ((R & ~31) + perm32(R & 31)) : R;
        voffA[i] = (unsigned)(R * g.lda + C) * 2u; voffB[i] = (unsigned)(Rb * g.ldb + C) * 2u; }
    const size_t kstep = (size_t)(BK * 2);
    const size_t hstepA = (size_t)HALF * g.lda * 2, hstepB = (size_t)HALF * g.ldb * 2;
    const size_t tstepA = 2 * hstepA, tstepB = 2 * hstepB;
    const unsigned ldsw = (unsigned)wid * 1024u;
    const int aoff = lds_byte(wr * 64 + fr, fq * 8), boff = lds_byte(wc * 32 + fr, fq * 8);
#define PG8_SA(b, h) (((b) * 2 + (h)) * HTB)
#define PG8_SB(b, h) ((4 + (b) * 2 + (h)) * HTB)
#define PG8_STAGE(bufoff, gbase, voff) do { _Pragma("unroll") for (int _i = 0; _i < 2; ++_i) \
        __builtin_amdgcn_global_load_lds((const unsigned*)((const char*)(gbase) + (voff)[_i]), (LAS unsigned*)(lds + (bufoff) + ldsw + _i * 8192), 16, 0, 0); } while (0)
#define PG8_LDA(dst, b, h) do { _Pragma("unroll") for (int m = 0; m < 4; ++m) _Pragma("unroll") for (int k = 0; k < 2; ++k) dst[m][k] = *(const LAS bf16x8*)(lds + PG8_SA(b, h) + aoff + m * 2048 + k * 1024); } while (0)
#define PG8_LDB(dst, b, h) do { _Pragma("unroll") for (int n = 0; n < 2; ++n) _Pragma("unroll") for (int k = 0; k < 2; ++k) dst[n][k] = *(const LAS bf16x8*)(lds + PG8_SB(b, h) + boff + n * 2048 + k * 1024); } while (0)
#define PG8_MMA(ai, bj, At, Bt) do { __builtin_amdgcn_s_setprio(1); _Pragma("unroll") for (int m = 0; m < 4; ++m) _Pragma("unroll") for (int n = 0; n < 2; ++n) _Pragma("unroll") for (int k = 0; k < 2; ++k) \
        acc[ai][bj][m][n] = __builtin_amdgcn_mfma_f32_16x16x32_bf16(Bt[n][k], At[m][k], acc[ai][bj][m][n], 0, 0, 0); __builtin_amdgcn_s_setprio(0); } while (0)
#define PG8_WAIT_V(n) asm volatile("s_waitcnt vmcnt(" #n ")" ::: "memory")
#define PG8_WAIT_L(n) asm volatile("s_waitcnt lgkmcnt(" #n ")" ::: "memory")
#define PG8_BAR __builtin_amdgcn_s_barrier()
#define PG8_SCHED __builtin_amdgcn_sched_barrier(0)
    Unit cur, nxt; int ui = 0;
    if (!S.next(0, cur)) return;
    f32x4 acc[2][2][4][2];
#pragma unroll
    for (int a = 0; a < 2; ++a)
#pragma unroll
        for (int b = 0; b < 2; ++b)
#pragma unroll
            for (int m = 0; m < 4; ++m)
#pragma unroll
                for (int n = 0; n < 2; ++n) acc[a][b][m][n] = (f32x4){0.f, 0.f, 0.f, 0.f};
    bf16x8 At[4][2], B0[2][2], B1[2][2];
    const char* cA = (const char*)(cur.sel ? g.A2 : g.A) + (size_t)cur.pm * tstepA + (size_t)cur.k0 * kstep; const char* cB = (const char*)(cur.sel ? g.Bt2 : g.Bt) + (size_t)cur.pn * tstepB + (size_t)cur.k0 * kstep;
    PG8_STAGE(PG8_SB(0, 0), cB, voffB); PG8_STAGE(PG8_SB(0, 1), cB + hstepB, voffB); PG8_STAGE(PG8_SA(0, 0), cA, voffA); PG8_STAGE(PG8_SA(0, 1), cA + hstepA, voffA);
    if (wr == 1) PG8_BAR;
    PG8_WAIT_V(2); PG8_BAR;
    PG8_STAGE(PG8_SB(1, 0), cB + kstep, voffB); PG8_STAGE(PG8_SA(1, 0), cA + kstep, voffA); PG8_STAGE(PG8_SB(1, 1), cB + hstepB + kstep, voffB);
    PG8_WAIT_V(6); PG8_BAR;
    for (;;) {
        const bool has_next = S.next(ui + 1, nxt);
        const char* nA = has_next ? (const char*)(nxt.sel ? g.A2 : g.A) + (size_t)nxt.pm * tstepA + (size_t)nxt.k0 * kstep : cA; const char* nB = has_next ? (const char*)(nxt.sel ? g.Bt2 : g.Bt) + (size_t)nxt.pn * tstepB + (size_t)nxt.k0 * kstep : cB;
        const int nt = cur.nt;
        for (int t = 0; t < nt; t += 2) {
            const bool last = (t == nt - 2);
            const char* a1 = cA + (size_t)(t + 1) * kstep;
            const char* a2 = last ? nA : cA + (size_t)(t + 2) * kstep; const char* b2 = last ? nB : cB + (size_t)(t + 2) * kstep;
            const char* a3 = a2 + kstep; const char* b3 = b2 + kstep;
            PG8_LDB(B0, 0, 0); PG8_LDB(B1, 0, 1); PG8_SCHED; PG8_LDA(At, 0, 0); PG8_STAGE(PG8_SA(1, 1), a1 + hstepA, voffA);
            PG8_WAIT_V(8); PG8_WAIT_L(0); PG8_BAR; PG8_MMA(0, 0, At, B0); PG8_MMA(0, 1, At, B1); PG8_BAR; PG8_SCHED;
            PG8_LDA(At, 0, 1); PG8_STAGE(PG8_SB(0, 0), b2, voffB); PG8_STAGE(PG8_SB(0, 1), b2 + hstepB, voffB); PG8_STAGE(PG8_SA(0, 0), a2, voffA);
            PG8_WAIT_V(8); PG8_WAIT_L(0); PG8_BAR; PG8_MMA(1, 0, At, B0); PG8_MMA(1, 1, At, B1); PG8_BAR; PG8_SCHED;
            PG8_LDB(B0, 1, 0); PG8_LDB(B1, 1, 1); PG8_SCHED; PG8_LDA(At, 1, 0); PG8_STAGE(PG8_SA(0, 1), a2 + hstepA, voffA);
            PG8_WAIT_V(8); PG8_WAIT_L(0); PG8_BAR; PG8_MMA(0, 0, At, B0); PG8_MMA(0, 1, At, B1); PG8_BAR; PG8_SCHED;
            PG8_LDA(At, 1, 1); PG8_STAGE(PG8_SB(1, 0), b3, voffB); PG8_STAGE(PG8_SB(1, 1), b3 + hstepB, voffB); PG8_STAGE(PG8_SA(1, 0), a3, voffA);
            PG8_WAIT_V(8); PG8_WAIT_L(0); PG8_BAR; PG8_MMA(1, 0, At, B0); PG8_MMA(1, 1, At, B1); PG8_BAR; PG8_SCHED;
        }
        if (wr == 0) PG8_BAR;
        E(acc, cur, wr, wc, fr, fq);
        if (!has_next) break;
#pragma unroll
        for (int a = 0; a < 2; ++a)
#pragma unroll
            for (int b = 0; b < 2; ++b)
#pragma unroll
                for (int m = 0; m < 4; ++m)
#pragma unroll
                    for (int n = 0; n < 2; ++n) acc[a][b][m][n] = (f32x4){0.f, 0.f, 0.f, 0.f};
        cur = nxt; cA = nA; cB = nB; ++ui;
        if (wr == 1) PG8_BAR;
    }
    PG8_WAIT_V(0);
    PG8_BAR;
#undef PG8_SA
#undef PG8_SB
#undef PG8_STAGE
#undef PG8_LDA
#undef PG8_LDB
#undef PG8_MMA
#undef PG8_WAIT_V
#undef PG8_WAIT_L
#undef PG8_BAR
#undef PG8_SCHED
}
}

struct Args {
    const float* in[30];
    float* out;
    unsigned char* ws;
    float inv_freq[32];
    int ph_lo, ph_hi, coop, pad;
};

struct Ctx {
    LAS unsigned char* lds;
    int tid, lane, wave, gw, ngw, G;
};

enum { WK_PLAIN = 0, WK_WIN, WK_UK, WK_UV };
DI int src_col(int kind, int n) {
    switch (kind) {
        case WK_WIN: return n < 2560 ? n : (n < 3648 ? n + 16 : (n < 3664 ? n - 1088 : -1));
        case WK_UK: return (n >> 7) * 256 + (n & 127);
        case WK_UV: return (n >> 7) * 256 + 128 + (n & 127);
        default: return n;
    }
}
DI void tr_item(const float* W, int Nsrc, int sc, bf16_t* WT, int ldt, int n0, int k0, LAS float* scr, int lane) {
    float tv[32];
#pragma unroll
    for (int i = 0; i < 32; ++i) { const int kk = 2 * i + (lane >> 5); tv[i] = sc >= 0 ? W[(size_t)(k0 + kk) * Nsrc + sc] : 0.f; }
#pragma unroll
    for (int i = 0; i < 32; ++i) { const int kk = 2 * i + (lane >> 5); scr[kk * 33 + (lane & 31)] = tv[i]; }
    asm volatile("s_waitcnt lgkmcnt(0)" ::: "memory");
    const int c = lane & 7;
#pragma unroll
    for (int j = 0; j < 4; ++j) { const int n = (lane >> 3) + 8 * j; const LAS float* s = scr + (8 * c) * 33 + n;
        u32x4 o; o.x = cvtpk(s[0 * 33], s[1 * 33]); o.y = cvtpk(s[2 * 33], s[3 * 33]); o.z = cvtpk(s[4 * 33], s[5 * 33]); o.w = cvtpk(s[6 * 33], s[7 * 33]);
        *(u32x4*)(WT + (size_t)(n0 + n) * ldt + k0 + 8 * c) = o; }
    asm volatile("s_waitcnt lgkmcnt(0)" ::: "memory");
}
DI void tr_matrix_item(int r, const float* W, int Nsrc, int K, int Nd, int kind, bf16_t* WT, LAS float* scr, int lane) {
    const int nblk = Nd / 32, kb = r / nblk, nb = r % nblk, n0 = 32 * nb;
    const int sc = src_col(kind, n0 + (lane & 31));
    tr_item(W, Nsrc, sc, WT, K, n0, 64 * kb, scr, lane);
}
DI void tr_gu_item(int r, const float* Wg, const float* Wu, bf16_t* WT, LAS float* scr, int lane) {
    const int nblk = 5632 / 32, kb = r / nblk, nb = r % nblk, n0 = 32 * nb;
    const int tile = n0 >> 8, within = n0 & 255;
    const float* W = within < 128 ? Wg : Wu;
    const int sc = tile * 128 + (within & 127) + (lane & 31);
    tr_item(W, DFF, sc, WT, DM, n0, 64 * kb, scr, lane);
}
DI void p0_prologue(const Args& a, const Ctx& c) {
    LAS float* scr = (LAS float*)(c.lds + c.wave * 16384);
    unsigned char* ws = a.ws;
    constexpr int I_GU = 16 * 176, I_D = 44 * 32, I_IN = 16 * 120, I_UQ = 8 * 48, I_UK = 8 * 32, I_OUT = 32 * 32;
    constexpr int NIT = 2 * I_GU + 2 * I_D + I_IN + I_UQ + 2 * I_UK + I_OUT;
    for (int it = c.gw; it < NIT; it += c.ngw) {
        int r = it;
        if (r < I_GU) { tr_gu_item(r, a.in[8], a.in[9], (bf16_t*)(ws + WS_WGU1), scr, c.lane); continue; } r -= I_GU;
        if (r < I_GU) { tr_gu_item(r, a.in[25], a.in[26], (bf16_t*)(ws + WS_WGU2), scr, c.lane); continue; } r -= I_GU;
        if (r < I_D) { tr_matrix_item(r, a.in[10], DM, DFF, DM, WK_PLAIN, (bf16_t*)(ws + WS_WD1), scr, c.lane); continue; } r -= I_D;
        if (r < I_D) { tr_matrix_item(r, a.in[27], DM, DFF, DM, WK_PLAIN, (bf16_t*)(ws + WS_WD2), scr, c.lane); continue; } r -= I_D;
        if (r < I_IN) { tr_matrix_item(r, a.in[11], 3664, DM, NIN, WK_WIN, (bf16_t*)(ws + WS_WIN), scr, c.lane); continue; } r -= I_IN;
        if (r < I_UQ) { tr_matrix_item(r, a.in[19], 1536, 512, 1536, WK_PLAIN, (bf16_t*)(ws + WS_WUQ), scr, c.lane); continue; } r -= I_UQ;
        if (r < I_UK) { tr_matrix_item(r, a.in[21], 2048, 512, 1024, WK_UK, (bf16_t*)(ws + WS_WUK), scr, c.lane); continue; } r -= I_UK;
        if (r < I_UK) { tr_matrix_item(r, a.in[21], 2048, 512, 1024, WK_UV, (bf16_t*)(ws + WS_WUV), scr, c.lane); continue; } r -= I_UK;
        tr_matrix_item(r, a.in[22], DM, 2048, DM, WK_PLAIN, (bf16_t*)(ws + WS_WOUT), scr, c.lane);
    }
    {
        bf16_t* xb = (bf16_t*)(ws + WS_HB);
        const int gt = blockIdx.x * 512 + c.tid, ngt = c.G * 512;
        for (int i0 = gt; i0 < T * DM / 8; i0 += 4 * ngt) {
            f32x4 va[4], vb[4];
#pragma unroll
            for (int k = 0; k < 4; ++k) { const int i = i0 + k * ngt; if (i < T * DM / 8) { const size_t e = (size_t)i * 8;
                const float* src = e < (size_t)TP * DM ? a.in[0] + e : a.in[1] + (e - (size_t)TP * DM); va[k] = *(const f32x4*)src; vb[k] = *(const f32x4*)(src + 4); } }
#pragma unroll
            for (int k = 0; k < 4; ++k) { const int i = i0 + k * ngt; if (i < T * DM / 8) {
                u32x4 w; w.x = cvtpk(va[k][0], va[k][1]); w.y = cvtpk(va[k][2], va[k][3]); w.z = cvtpk(vb[k][0], vb[k][1]); w.w = cvtpk(vb[k][2], vb[k][3]);
                *(u32x4*)(xb + (size_t)i * 8) = w; } }
        }
        float* rc = (float*)(ws + WS_ROPE); float* rs = rc + 65536;
        for (int i = gt; i < 65536; i += ngt) {
            const int pos = i >> 5, k = i & 31;
            const float ang = (float)pos * a.inv_freq[k];
            const double x = (double)ang;
            const double q = rint(x * 0.6366197723675814);
            const double r = x - q * 1.5707963267948966;
            const double r2 = r * r;
            const double sn = r * (1.0 + r2 * (-1.0 / 6 + r2 * (1.0 / 120 + r2 * (-1.0 / 5040 + r2 * (1.0 / 362880 + r2 * (-1.0 / 39916800))))));
            const double cs = 1.0 + r2 * (-0.5 + r2 * (1.0 / 24 + r2 * (-1.0 / 720 + r2 * (1.0 / 40320 + r2 * (-1.0 / 3628800 + r2 * (1.0 / 479001600))))));
            const int qi = ((int)q) & 3;
            const double cc = qi == 0 ? cs : (qi == 1 ? -sn : (qi == 2 ? -cs : sn));
            const double ss = qi == 0 ? sn : (qi == 1 ? cs : (qi == 2 ? -sn : -cs));
            rc[i] = (float)cc; rs[i] = (float)ss;
        }
    }
}

struct LnRow { f32x4 v0, v1, v2, v3; };
DI void ln_finish(LnRow& r, const f32x4 (&g)[4], const f32x4 (&b)[4]) {
    float s = (r.v0[0] + r.v0[1]) + (r.v0[2] + r.v0[3]) + (r.v1[0] + r.v1[1]) + (r.v1[2] + r.v1[3]) + (r.v2[0] + r.v2[1]) + (r.v2[2] + r.v2[3]) + (r.v3[0] + r.v3[1]) + (r.v3[2] + r.v3[3]);
    const float mean = wave_sum(s) * (1.f / DM);
    r.v0 = r.v0 - mean; r.v1 = r.v1 - mean; r.v2 = r.v2 - mean; r.v3 = r.v3 - mean;
    float q = (r.v0[0] * r.v0[0] + r.v0[1] * r.v0[1]) + (r.v0[2] * r.v0[2] + r.v0[3] * r.v0[3]) + (r.v1[0] * r.v1[0] + r.v1[1] * r.v1[1]) + (r.v1[2] * r.v1[2] + r.v1[3] * r.v1[3])
            + (r.v2[0] * r.v2[0] + r.v2[1] * r.v2[1]) + (r.v2[2] * r.v2[2] + r.v2[3] * r.v2[3]) + (r.v3[0] * r.v3[0] + r.v3[1] * r.v3[1]) + (r.v3[2] * r.v3[2] + r.v3[3] * r.v3[3]);
    const float rstd = 1.0f / sqrtf(wave_sum(q) * (1.f / DM) + EPS);
    r.v0 = r.v0 * rstd * g[0] + b[0]; r.v1 = r.v1 * rstd * g[1] + b[1]; r.v2 = r.v2 * rstd * g[2] + b[2]; r.v3 = r.v3 * rstd * g[3] + b[3];
}
DI void ln_store(const LnRow& r, int row, bf16_t* hb, float* fo, int lane) {
    if (hb) {
        bf16_t* o = hb + (size_t)row * DM + 4 * lane;
        *(u32x2*)o = (u32x2){cvtpk(r.v0[0], r.v0[1]), cvtpk(r.v0[2], r.v0[3])}; *(u32x2*)(o + 256) = (u32x2){cvtpk(r.v1[0], r.v1[1]), cvtpk(r.v1[2], r.v1[3])};
        *(u32x2*)(o + 512) = (u32x2){cvtpk(r.v2[0], r.v2[1]), cvtpk(r.v2[2], r.v2[3])}; *(u32x2*)(o + 768) = (u32x2){cvtpk(r.v3[0], r.v3[1]), cvtpk(r.v3[2], r.v3[3])};
    }
    if (fo) {
        float* o = fo + (size_t)row * DM + 4 * lane;
        *(f32x4*)o = r.v0; *(f32x4*)(o + 256) = r.v1; *(f32x4*)(o + 512) = r.v2; *(f32x4*)(o + 768) = r.v3;
    }
}
DI void ln_pass(const float* R, const float* g, const float* b, bf16_t* hb, float* fo, const Ctx& c, const float* part, int S, const float* xres, const bf16_t* hres, float sc) {
    f32x4 gg[4], bb[4];
#pragma unroll
    for (int j = 0; j < 4; ++j) { gg[j] = *(const f32x4*)(g + 256 * j + 4 * c.lane); bb[j] = *(const f32x4*)(b + 256 * j + 4 * c.lane); }
    for (int row = c.gw; row < TP; row += 2 * c.ngw) {
        const int row2 = row + c.ngw; const bool has2 = row2 < TP; const int r2 = has2 ? row2 : row;
        const float* xa = R + (size_t)row * DM + 4 * c.lane; const float* xb = R + (size_t)r2 * DM + 4 * c.lane;
        LnRow A, B;
        A.v0 = *(const f32x4*)xa; A.v1 = *(const f32x4*)(xa + 256); A.v2 = *(const f32x4*)(xa + 512); A.v3 = *(const f32x4*)(xa + 768);
        B.v0 = *(const f32x4*)xb; B.v1 = *(const f32x4*)(xb + 256); B.v2 = *(const f32x4*)(xb + 512); B.v3 = *(const f32x4*)(xb + 768);
        ln_finish(A, gg, bb); ln_finish(B, gg, bb);
        ln_store(A, row, hb, fo, c.lane);
        if (has2) ln_store(B, row2, hb, fo, c.lane);
    }
    for (int row = TP + c.gw; row < T; row += c.ngw) {
        const size_t ro = (size_t)(row - TP) * DM + 4 * c.lane;
        LnRow A; A.v0 = (f32x4){0.f, 0.f, 0.f, 0.f}; A.v1 = A.v0; A.v2 = A.v0; A.v3 = A.v0;
        for (int k = 0; k < S; ++k) { const float* pp = part + (size_t)k * (TS * DM) + ro; A.v0 += *(const f32x4*)pp; A.v1 += *(const f32x4*)(pp + 256); A.v2 += *(const f32x4*)(pp + 512); A.v3 += *(const f32x4*)(pp + 768); }
        f32x4 r0, r1, r2, r3;
        if (xres) { const float* xp = xres + ro; r0 = *(const f32x4*)xp; r1 = *(const f32x4*)(xp + 256); r2 = *(const f32x4*)(xp + 512); r3 = *(const f32x4*)(xp + 768); }
        else { const bf16_t* hp = hres + (size_t)row * DM + 4 * c.lane;
            const u32x2 w0 = *(const u32x2*)hp, w1 = *(const u32x2*)(hp + 256), w2 = *(const u32x2*)(hp + 512), w3 = *(const u32x2*)(hp + 768);
            r0 = (f32x4){bflo(w0.x), bfhi(w0.x), bflo(w0.y), bfhi(w0.y)}; r1 = (f32x4){bflo(w1.x), bfhi(w1.x), bflo(w1.y), bfhi(w1.y)};
            r2 = (f32x4){bflo(w2.x), bfhi(w2.x), bflo(w2.y), bfhi(w2.y)}; r3 = (f32x4){bflo(w3.x), bfhi(w3.x), bflo(w3.y), bfhi(w3.y)}; }
        A.v0 = r0 * ALPHA + A.v0 * sc; A.v1 = r1 * ALPHA + A.v1 * sc; A.v2 = r2 * ALPHA + A.v2 * sc; A.v3 = r3 * ALPHA + A.v3 * sc;
        ln_finish(A, gg, bb);
        ln_store(A, row, hb, fo, c.lane);
    }
}

DI void post_proj(const Args& a, const Ctx& c) {
    unsigned char* ws = a.ws;
    bf16_t* MISC = (bf16_t*)(ws + A_MISC); const bf16_t* XBC = (const bf16_t*)(ws + A_XBC);
    bf16_t* MIX = (bf16_t*)(a.out + O_Y); bf16_t* BC = (bf16_t*)(ws + A_BC); float* DT = (float*)(ws + A_DT);
    const float* rc = (const float*)(ws + WS_ROPE); const float* rs = rc + 65536;
    const float* conv_w = a.in[12]; const float* conv_b = a.in[13]; const float* dt_bias = a.in[14];
    const float* qg = a.in[18]; const float* kvg = a.in[20]; const float* sconv = a.in[4];
    const int lane = c.lane;
    const f32x4 qga = *(const f32x4*)(qg + 8 * lane), qgb = *(const f32x4*)(qg + 8 * lane + 4), kga = *(const f32x4*)(kvg + 8 * lane), kgb = *(const f32x4*)(kvg + 8 * lane + 4);
    const float dtb = dt_bias[lane & 15];
    for (int r = c.gw; r < T; r += c.ngw) {
        const bool smp = r >= TP;
        const int rr = r - TP;
        const int b = smp ? (rr >> 5) : (r >> 11), t = smp ? (rr & 31) : (r & 2047), pos = smp ? 1024 + t : t, L = smp ? 32 : 2048;
        bf16_t* mrow = MISC + (size_t)r * 1280;
        const u32x4 wq = *(const u32x4*)(mrow + 8 * lane), wkv = *(const u32x4*)(mrow + 512 + 8 * lane);
        const float x1 = bf2f(mrow[1024 + (lane & 31)]), x2 = bf2f(mrow[1056 + (lane & 31)]);
        const float draw = bf2f(mrow[1088 + (lane & 15)]);
        const float cs = rc[pos * 32 + (lane & 31)], sn = rs[pos * 32 + (lane & 31)];
        u32x4 xin[3][4];
#pragma unroll
        for (int it = 0; it < 3; ++it)
#pragma unroll
            for (int k = 0; k < 4; ++k) {
                const int tt = t - 3 + k, ch = it * 512 + 8 * lane;
                if (tt >= 0) xin[it][k] = *(const u32x4*)(XBC + (size_t)(r - 3 + k) * 1536 + ch);
                else if (smp) { const float* sp = sconv + ((size_t)b * 3 + (tt + 3)) * 1536 + ch; const f32x4 xa = *(const f32x4*)sp, xb = *(const f32x4*)(sp + 4);
                    xin[it][k].x = cvtpk(xa[0], xa[1]); xin[it][k].y = cvtpk(xa[2], xa[3]); xin[it][k].z = cvtpk(xb[0], xb[1]); xin[it][k].w = cvtpk(xb[2], xb[3]); }
                else xin[it][k] = (u32x4){0u, 0u, 0u, 0u};
            }
        f32x8 vq = unpack8(wq), vk = unpack8(wkv);
        float sq = 0.f, sk = 0.f;
#pragma unroll
        for (int j = 0; j < 8; ++j) { sq += vq[j] * vq[j]; sk += vk[j] * vk[j]; }
#pragma unroll
        for (int o = 1; o < 64; o <<= 1) { sq += __shfl_xor(sq, o); sk += __shfl_xor(sk, o); }
        const float rq = 1.0f / sqrtf(sq * (1.f / 512) + EPS), rk = 1.0f / sqrtf(sk * (1.f / 512) + EPS);
#pragma unroll
        for (int j = 0; j < 4; ++j) { vq[j] = vq[j] * rq * qga[j]; vq[4 + j] = vq[4 + j] * rq * qgb[j]; vk[j] = vk[j] * rk * kga[j]; vk[4 + j] = vk[4 + j] * rk * kgb[j]; }
        u32x4 cout[3];
        int ln = lane; asm volatile("" : "+v"(ln));
#pragma unroll
        for (int it = 0; it < 3; ++it) {
            const int ch = it * 512 + 8 * ln;
            f32x8 acc; { const f32x4 ba = *(const f32x4*)(conv_b + ch), bb = *(const f32x4*)(conv_b + ch + 4); acc = (f32x8){ba[0], ba[1], ba[2], ba[3], bb[0], bb[1], bb[2], bb[3]}; }
#pragma unroll
            for (int k = 0; k < 4; ++k) {
                const f32x8 x = unpack8(xin[it][k]);
                const f32x4 wa = *(const f32x4*)(conv_w + k * 1536 + ch), wb = *(const f32x4*)(conv_w + k * 1536 + ch + 4);
#pragma unroll
                for (int j = 0; j < 4; ++j) { acc[j] += x[j] * wa[j]; acc[4 + j] += x[4 + j] * wb[j]; }
            }
#pragma unroll
            for (int j = 0; j < 8; ++j) acc[j] = silu_f(acc[j]);
            cout[it] = pack8(acc);
        }
        *(u32x4*)(mrow + 8 * lane) = pack8(vq);
        *(u32x4*)(mrow + 512 + 8 * lane) = pack8(vk);
        {
            float* lo = smp ? a.out + O_LATS + (size_t)rr * 512 : a.out + O_LATP + (size_t)r * 512;
            *(f32x4*)(lo + 8 * lane) = (f32x4){vk[0], vk[1], vk[2], vk[3]}; *(f32x4*)(lo + 8 * lane + 4) = (f32x4){vk[4], vk[5], vk[6], vk[7]};
        }
        if (lane < 32) {
            const float o1 = x1 * cs - x2 * sn, o2 = x1 * sn + x2 * cs;
            float* ko = smp ? a.out + O_KRS + (size_t)rr * 64 : a.out + O_KRP + (size_t)r * 64;
            ko[lane] = o1; ko[32 + lane] = o2;
            mrow[1024 + lane] = (bf16_t)(cvtpk(o1, 0.f) & 0xffffu); mrow[1056 + lane] = (bf16_t)(cvtpk(o2, 0.f) & 0xffffu);
        } else if (lane < 48) {
            const float v = draw + dtb;
            DT[(size_t)r * 16 + (lane - 32)] = fmaxf(v, 0.f) + log1pf(expf(-fabsf(v)));
        }
        *(u32x4*)(MIX + (size_t)r * 2048 + 8 * lane) = cout[0];
        *(u32x4*)(MIX + (size_t)r * 2048 + 512 + 8 * lane) = cout[1];
        *(u32x4*)(BC + (size_t)r * 512 + 8 * lane) = cout[2];
        if (t >= L - 3) {
#pragma unroll
            for (int it = 0; it < 3; ++it) {
                const int ch = it * 512 + 8 * lane;
                const f32x8 cur = unpack8(xin[it][3]);
                float* co = smp ? a.out + O_CONVS + ((size_t)b * 3 + (t - (L - 3))) * 1536 + ch : a.out + O_CONVP + ((size_t)b * 3 + (t - (L - 3))) * 1536 + ch;
                *(f32x4*)co = (f32x4){cur[0], cur[1], cur[2], cur[3]}; *(f32x4*)(co + 4) = (f32x4){cur[4], cur[5], cur[6], cur[7]};
            }
        }
    }
}

constexpr int SB_ROW = 272, SX_ROW = 1040;
constexpr int L_BS = 0, L_CS = 64 * SB_ROW, L_XS = 2 * 64 * SB_ROW, L_WS = L_XS + 64 * SX_ROW;
DI void ssd_decode_item(int it, int& row0, int& nib, int& g, int& b, int& sbase, bool& smp) {
    if (it < 512) { b = it >> 6; const int ch = (it >> 1) & 31; g = it & 1; row0 = b * 2048 + 64 * ch; nib = 2; sbase = (b * 32 + ch) * 16; smp = false; }
    else { const int j = it - 512; b = j >> 1; g = j & 1; row0 = TP + 32 * b; nib = 1; sbase = 4096 + b * 16; smp = true; }
}
DI void ssd_load_chunk(const Ctx& c, const bf16_t* BC, const bf16_t* MIX, int row0, int nrows, int g, bool needC) {
    LAS unsigned char* L = c.lds;
    u32x4 vb[2], vc[2], vx[8];
#pragma unroll
    for (int k = 0; k < 2; ++k) { const int i = c.tid + 512 * k, r = i >> 4, cc = i & 15;
        if (r < nrows) { vb[k] = *(const u32x4*)(BC + (size_t)(row0 + r) * 512 + g * 128 + cc * 8); if (needC) vc[k] = *(const u32x4*)(BC + (size_t)(row0 + r) * 512 + 256 + g * 128 + cc * 8); } }
#pragma unroll
    for (int k = 0; k < 8; ++k) { const int i = c.tid + 512 * k, r = i >> 6, cc = i & 63;
        if (r < nrows) vx[k] = *(const u32x4*)(MIX + (size_t)(row0 + r) * 2048 + g * 512 + cc * 8); }
#pragma unroll
    for (int k = 0; k < 2; ++k) { const int i = c.tid + 512 * k, r = i >> 4, cc = i & 15;
        if (r < nrows) { *(LAS u32x4*)(L + L_BS + r * SB_ROW + cc * 16) = vb[k]; if (needC) *(LAS u32x4*)(L + L_CS + r * SB_ROW + cc * 16) = vc[k]; } }
#pragma unroll
    for (int k = 0; k < 8; ++k) { const int i = c.tid + 512 * k, r = i >> 6, cc = i & 63;
        if (r < nrows) *(LAS u32x4*)(L + L_XS + r * SX_ROW + cc * 16) = vx[k]; }
}
DI void ssd_a(const Args& a, const Ctx& c) {
    unsigned char* ws = a.ws;
    const bf16_t* MIX = (const bf16_t*)(a.out + O_Y); const bf16_t* BC = (const bf16_t*)(ws + A_BC); const float* DT = (const float*)(ws + A_DT);
    bf16_t* ST = (bf16_t*)(ws + A_ST); float* DEC = (float*)(ws + A_DEC);
    const float* a_log = a.in[15];
    LAS unsigned char* L = c.lds;
    LAS float* wsm = (LAS float*)(L + L_WS + c.wave * 512);
    const int lane = c.lane, r = lane & 31, kg = lane >> 5, w = c.wave;
    for (int it = blockIdx.x; it < 544; it += c.G) {
        int row0, nib, g, b, sbase; bool smp;
        ssd_decode_item(it, row0, nib, g, b, sbase, smp);
        const int nj = 32 * nib, h = 8 * g + w, item = sbase + h;
        ssd_load_chunk(c, BC, MIX, row0, nj, g, false);
        const float dtv = lane < nj ? DT[(size_t)(row0 + lane) * 16 + h] : 0.f;
        const float Ah = -expf(a_log[h]);
        float acs = dtv * Ah;
#pragma unroll
        for (int d = 1; d < 64; d <<= 1) { const float tv = __shfl_up(acs, d); if (lane >= d) acs += tv; }
        const float alast = __shfl(acs, nj - 1);
        wsm[lane] = dtv * expf(alast - acs);
        if (lane == 0) DEC[item] = expf(alast);
        __syncthreads();
        f32x16 acc[2][4];
#pragma unroll
        for (int pb = 0; pb < 2; ++pb)
#pragma unroll
            for (int nb = 0; nb < 4; ++nb)
#pragma unroll
                for (int e = 0; e < 16; ++e) acc[pb][nb][e] = 0.f;
        const int ns = nj >> 4;
        for (int s = 0; s < ns; ++s) {
            const int j0 = 16 * s + 8 * kg;
            f32x8 wv;
#pragma unroll
            for (int jj = 0; jj < 8; ++jj) wv[jj] = wsm[j0 + jj];
            bf16x8 af[2];
#pragma unroll
            for (int pb = 0; pb < 2; ++pb) {
                f32x8 x;
#pragma unroll
                for (int jj = 0; jj < 8; ++jj) x[jj] = bf2f(*(const LAS bf16_t*)(L + L_XS + (j0 + jj) * SX_ROW + (w * 64 + 32 * pb + r) * 2)) * wv[jj];
                af[pb] = __builtin_bit_cast(bf16x8, pack8(x));
            }
#pragma unroll
            for (int nb = 0; nb < 4; ++nb) {
                bf16x8 bfr;
#pragma unroll
                for (int jj = 0; jj < 8; ++jj) bfr[jj] = (short)*(const LAS bf16_t*)(L + L_BS + (j0 + jj) * SB_ROW + (32 * nb + r) * 2);
                acc[0][nb] = MFMA32(af[0], bfr, acc[0][nb]);
                acc[1][nb] = MFMA32(af[1], bfr, acc[1][nb]);
            }
        }
        __syncthreads();
        LAS unsigned char* stg = L + w * 16384;
#pragma unroll
        for (int pb = 0; pb < 2; ++pb)
#pragma unroll
            for (int nb = 0; nb < 4; ++nb)
#pragma unroll
                for (int e = 0; e < 16; ++e) *(LAS bf16_t*)(stg + ((32 * pb + crow(e, kg)) * 128 + 32 * nb + r) * 2) = (bf16_t)(cvtpk(acc[pb][nb][e], 0.f) & 0xffffu);
        asm volatile("s_waitcnt lgkmcnt(0)" ::: "memory");
        bf16_t* so = ST + (size_t)item * 8192;
#pragma unroll
        for (int k = 0; k < 16; ++k) *(u32x4*)(so + (k * 64 + lane) * 8) = *(const LAS u32x4*)(stg + (k * 64 + lane) * 16);
        __syncthreads();
    }
}
DI void ssd_scan(const Args& a, const Ctx& c) {
    unsigned char* ws = a.ws;
    bf16_t* ST = (bf16_t*)(ws + A_ST); const float* DEC = (const float*)(ws + A_DEC);
    const int gt = blockIdx.x * 512 + c.tid, ngt = c.G * 512;
    for (int i = gt; i < 131072; i += ngt) {
        const int b = i >> 14, h = (i >> 10) & 15, e = (i & 1023) * 8;
        f32x8 hv = (f32x8){0.f, 0.f, 0.f, 0.f, 0.f, 0.f, 0.f, 0.f};
        for (int cb = 0; cb < 32; cb += 8) {
            u32x4 sv[8]; float dec[8];
#pragma unroll
            for (int k = 0; k < 8; ++k) { const int item = (b * 32 + cb + k) * 16 + h; sv[k] = *(const u32x4*)(ST + (size_t)item * 8192 + e); dec[k] = DEC[item]; }
#pragma unroll
            for (int k = 0; k < 8; ++k) { const int item = (b * 32 + cb + k) * 16 + h; *(u32x4*)(ST + (size_t)item * 8192 + e) = pack8(hv); hv = hv * dec[k] + unpack8(sv[k]); }
        }
        float* o = a.out + O_SSMP + (size_t)(b * 16 + h) * 8192 + e;
        *(f32x4*)o = (f32x4){hv[0], hv[1], hv[2], hv[3]}; *(f32x4*)(o + 4) = (f32x4){hv[4], hv[5], hv[6], hv[7]};
    }
    const float* h0 = a.in[5];
    for (int i = gt; i < 262144; i += ngt) {
        const int bh = i >> 10, e = (i & 1023) * 8;
        const float* hp = h0 + (size_t)bh * 8192 + e;
        const f32x4 ha = *(const f32x4*)hp, hb = *(const f32x4*)(hp + 4);
        const f32x8 sv = unpack8(*(const u32x4*)(ST + (size_t)(4096 + bh) * 8192 + e));
        const float dec = DEC[4096 + bh];
        float* o = a.out + O_SSMS + (size_t)bh * 8192 + e;
        *(f32x4*)o = (f32x4){ha[0] * dec + sv[0], ha[1] * dec + sv[1], ha[2] * dec + sv[2], ha[3] * dec + sv[3]};
        *(f32x4*)(o + 4) = (f32x4){hb[0] * dec + sv[4], hb[1] * dec + sv[5], hb[2] * dec + sv[6], hb[3] * dec + sv[7]};
    }
}
DI void ssd_c(const Args& a, const Ctx& c) {
    unsigned char* ws = a.ws;
    bf16_t* MIX = (bf16_t*)(a.out + O_Y); const bf16_t* BC = (const bf16_t*)(ws + A_BC); const float* DT = (const float*)(ws + A_DT);
    const bf16_t* ST = (const bf16_t*)(ws + A_ST); const bf16_t* Z = (const bf16_t*)(ws + A_Z);
    const float* a_log = a.in[15]; const float* d_skip = a.in[16]; const float* ng = a.in[17]; const float* h0 = a.in[5];
    LAS unsigned char* L = c.lds;
    LAS float* wacs = (LAS float*)(L + L_WS + c.wave * 512); LAS float* wdt = wacs + 64;
    LAS float* part = (LAS float*)(L + L_WS + 4096);
    const int lane = c.lane, il = lane & 31, hi = lane >> 5, w = c.wave;
    for (int it = blockIdx.x; it < 544; it += c.G) {
        int row0, nib, g, b, sbase; bool smp;
        ssd_decode_item(it, row0, nib, g, b, sbase, smp);
        const int h = 8 * g + w, nj = 32 * nib;
        ssd_load_chunk(c, BC, MIX, row0, nj, g, true);
        const float dtv = lane < nj ? DT[(size_t)(row0 + lane) * 16 + h] : 0.f;
        const float Ah = -expf(a_log[h]);
        float acs = dtv * Ah;
#pragma unroll
        for (int d = 1; d < 64; d <<= 1) { const float tv = __shfl_up(acs, d); if (lane >= d) acs += tv; }
        wacs[lane] = acs; wdt[lane] = dtv;
        __syncthreads();
        f32x16 Y[2][2];
#pragma unroll
        for (int pb = 0; pb < 2; ++pb)
#pragma unroll
            for (int ib = 0; ib < 2; ++ib)
#pragma unroll
                for (int e = 0; e < 16; ++e) Y[pb][ib][e] = 0.f;
        const LAS unsigned char* cl0 = L + L_CS + il * SB_ROW + 16 * hi;
        if (!smp) {
            const bf16_t* hp = ST + (size_t)(sbase + h) * 8192 + (size_t)il * 128 + 8 * hi;
#pragma unroll 4
            for (int s = 0; s < 8; ++s) {
                const bf16x8 af0 = *(const bf16x8*)(hp + 16 * s), af1 = *(const bf16x8*)(hp + 32 * 128 + 16 * s);
                const bf16x8 c0 = *(const LAS bf16x8*)(cl0 + 32 * s), c1 = *(const LAS bf16x8*)(cl0 + 32 * SB_ROW + 32 * s);
                Y[0][0] = MFMA32(af0, c0, Y[0][0]); Y[1][0] = MFMA32(af1, c0, Y[1][0]);
                Y[0][1] = MFMA32(af0, c1, Y[0][1]); Y[1][1] = MFMA32(af1, c1, Y[1][1]);
            }
        } else {
            const float* hp = h0 + (size_t)(sbase - 4096 + h) * 8192 + (size_t)il * 128 + 8 * hi;
#pragma unroll 2
            for (int s = 0; s < 8; ++s) {
                bf16x8 af[2];
#pragma unroll
                for (int pb = 0; pb < 2; ++pb) { const f32x4 x0 = *(const f32x4*)(hp + pb * 4096 + 16 * s), x1 = *(const f32x4*)(hp + pb * 4096 + 16 * s + 4);
                    u32x4 pk; pk.x = cvtpk(x0[0], x0[1]); pk.y = cvtpk(x0[2], x0[3]); pk.z = cvtpk(x1[0], x1[1]); pk.w = cvtpk(x1[2], x1[3]); af[pb] = __builtin_bit_cast(bf16x8, pk); }
                const bf16x8 c0 = *(const LAS bf16x8*)(cl0 + 32 * s);
                Y[0][0] = MFMA32(af[0], c0, Y[0][0]); Y[1][0] = MFMA32(af[1], c0, Y[1][0]);
            }
        }
        {
            const float ea0 = expf(wacs[il]), ea1 = expf(wacs[32 + il]);
#pragma unroll
            for (int e = 0; e < 16; ++e) { Y[0][0][e] *= ea0; Y[1][0][e] *= ea0; Y[0][1][e] *= ea1; Y[1][1][e] *= ea1; }
        }
        for (int jb = 0; jb < nib; ++jb) {
            f32x16 MT[2];
#pragma unroll
            for (int e = 0; e < 16; ++e) { MT[0][e] = 0.f; MT[1][e] = 0.f; }
            const LAS unsigned char* bl = L + L_BS + (32 * jb + il) * SB_ROW + 16 * hi;
#pragma unroll
            for (int s = 0; s < 8; ++s) {
                const bf16x8 bf_ = *(const LAS bf16x8*)(bl + 32 * s);
                if (jb == 0) { const bf16x8 c0 = *(const LAS bf16x8*)(cl0 + 32 * s); MT[0] = MFMA32(bf_, c0, MT[0]); }
                if (nib == 2) { const bf16x8 c1 = *(const LAS bf16x8*)(cl0 + 32 * SB_ROW + 32 * s); MT[1] = MFMA32(bf_, c1, MT[1]); }
            }
            const float ai0 = wacs[il], ai1 = wacs[32 + il];
#pragma unroll
            for (int e = 0; e < 16; ++e) {
                const int jl = crow(e, hi), j = 32 * jb + jl;
                const float aj = wacs[j], dj = wdt[j];
                if (jb == 0) {
                    MT[0][e] *= (jl <= il) ? expf(ai0 - aj) * dj : 0.f;
                    MT[1][e] *= expf(fminf(ai1 - aj, 0.f)) * dj;
                } else {
                    MT[1][e] *= (jl <= il) ? expf(ai1 - aj) * dj : 0.f;
                }
            }
#pragma unroll
            for (int s2 = 0; s2 < 2; ++s2) {
                u32x4 p0, p1;
                p0.x = cvtpk(MT[0][8 * s2 + 0], MT[0][8 * s2 + 1]); p0.y = cvtpk(MT[0][8 * s2 + 2], MT[0][8 * s2 + 3]); p0.z = cvtpk(MT[0][8 * s2 + 4], MT[0][8 * s2 + 5]); p0.w = cvtpk(MT[0][8 * s2 + 6], MT[0][8 * s2 + 7]);
                p1.x = cvtpk(MT[1][8 * s2 + 0], MT[1][8 * s2 + 1]); p1.y = cvtpk(MT[1][8 * s2 + 2], MT[1][8 * s2 + 3]); p1.z = cvtpk(MT[1][8 * s2 + 4], MT[1][8 * s2 + 5]); p1.w = cvtpk(MT[1][8 * s2 + 6], MT[1][8 * s2 + 7]);
                const bf16x8 pf0 = __builtin_bit_cast(bf16x8, p0), pf1 = __builtin_bit_cast(bf16x8, p1);
#pragma unroll
                for (int pb = 0; pb < 2; ++pb) {
                    bf16x8 af;
#pragma unroll
                    for (int jj = 0; jj < 8; ++jj) { const int j = 32 * jb + 16 * s2 + 8 * (jj >> 2) + 4 * hi + (jj & 3); af[jj] = (short)*(const LAS bf16_t*)(L + L_XS + j * SX_ROW + (w * 64 + 32 * pb + il) * 2); }
                    if (jb == 0) Y[pb][0] = MFMA32(af, pf0, Y[pb][0]);
                    if (nib == 2) Y[pb][1] = MFMA32(af, pf1, Y[pb][1]);
                }
            }
        }
        const float dsk = d_skip[h];
        float ssq0 = 0.f, ssq1 = 0.f;
#pragma unroll
        for (int ib = 0; ib < 2; ++ib) {
            if (ib < nib) {
                const size_t row = (size_t)(row0 + 32 * ib + il);
#pragma unroll
                for (int pb = 0; pb < 2; ++pb)
#pragma unroll
                    for (int gq = 0; gq < 4; ++gq) {
                        const int p0 = 32 * pb + 8 * gq + 4 * hi;
                        const u32x2 xw = *(const LAS u32x2*)(L + L_XS + (32 * ib + il) * SX_ROW + (w * 64 + p0) * 2), zw = *(const u32x2*)(Z + row * 1024 + h * 64 + p0);
                        const float xv[4] = {bflo(xw.x), bfhi(xw.x), bflo(xw.y), bfhi(xw.y)}, zv[4] = {bflo(zw.x), bfhi(zw.x), bflo(zw.y), bfhi(zw.y)};
#pragma unroll
                        for (int e = 0; e < 4; ++e) { float y = Y[pb][ib][4 * gq + e] + dsk * xv[e]; y *= silu_f(zv[e]); Y[pb][ib][4 * gq + e] = y; if (ib == 0) ssq0 += y * y; else ssq1 += y * y; }
                    }
            }
        }
        ssq0 += __shfl_xor(ssq0, 32); ssq1 += __shfl_xor(ssq1, 32);
        if (hi == 0) { part[w * 64 + il] = ssq0; part[w * 64 + 32 + il] = ssq1; }
        __syncthreads();
        float t0 = 0.f, t1 = 0.f;
#pragma unroll
        for (int ww = 0; ww < 8; ++ww) { t0 += part[ww * 64 + il]; t1 += part[ww * 64 + 32 + il]; }
        const float rs0 = 1.0f / sqrtf(t0 * (1.f / 512) + EPS), rs1 = 1.0f / sqrtf(t1 * (1.f / 512) + EPS);
#pragma unroll
        for (int ib = 0; ib < 2; ++ib) {
            if (ib < nib) {
                const size_t row = (size_t)(row0 + 32 * ib + il);
                const float rs = ib == 0 ? rs0 : rs1;
#pragma unroll
                for (int pb = 0; pb < 2; ++pb)
#pragma unroll
                    for (int gq = 0; gq < 4; ++gq) {
                        const int p0 = 32 * pb + 8 * gq + 4 * hi;
                        const f32x4 gn = *(const f32x4*)(ng + h * 64 + p0);
                        u32x2 o; o.x = cvtpk(Y[pb][ib][4 * gq + 0] * rs * gn[0], Y[pb][ib][4 * gq + 1] * rs * gn[1]); o.y = cvtpk(Y[pb][ib][4 * gq + 2] * rs * gn[2], Y[pb][ib][4 * gq + 3] * rs * gn[3]);
                        *(u32x2*)(MIX + row * 2048 + h * 64 + p0) = o;
                    }
            }
        }
        __syncthreads();
    }
}

DI void load_q_frags(bf16x8 (&qf)[12], const bf16_t* Qrow, int ldq, const float* rc, const float* rs, int pos0, int lane) {
    const int q = lane & 31, hi = lane >> 5;
    constexpr float SC = 0.07216878364870322f * 1.4426950408889634f;
    const bf16_t* qp = Qrow + (size_t)q * ldq + 8 * hi;
#pragma unroll
    for (int s = 0; s < 8; ++s) { f32x8 v = unpack8(*(const u32x4*)(qp + 16 * s)); v = v * SC; qf[s] = __builtin_bit_cast(bf16x8, pack8(v)); }
    const float* cp = rc + (size_t)(pos0 + q) * 32; const float* sp = rs + (size_t)(pos0 + q) * 32;
#pragma unroll
    for (int s = 0; s < 2; ++s) {
        const f32x8 x1 = unpack8(*(const u32x4*)(qp + 128 + 16 * s)), x2 = unpack8(*(const u32x4*)(qp + 160 + 16 * s));
        const int i0 = 16 * s + 8 * hi;
        f32x8 o1, o2;
#pragma unroll
        for (int jj = 0; jj < 8; ++jj) { const float cs = cp[i0 + jj], sn = sp[i0 + jj]; o1[jj] = (x1[jj] * cs - x2[jj] * sn) * SC; o2[jj] = (x1[jj] * sn + x2[jj] * cs) * SC; }
        qf[8 + s] = __builtin_bit_cast(bf16x8, pack8(o1)); qf[10 + s] = __builtin_bit_cast(bf16x8, pack8(o2));
    }
}
DI void softmax_step(f32x16& st, float& m, float& l, f32x16& o0, f32x16& o1, f32x16& o2, f32x16& o3, bf16x8& pf0, bf16x8& pf1) {
    float mx = st[0];
#pragma unroll
    for (int e = 1; e < 16; ++e) mx = fmaxf(mx, st[e]);
    mx = fmaxf(mx, __shfl_xor(mx, 32));
    const float mn = fmaxf(m, mx);
    const float alpha = __builtin_amdgcn_exp2f(m - mn);
    m = mn;
    float ps = 0.f;
#pragma unroll
    for (int e = 0; e < 16; ++e) { st[e] = __builtin_amdgcn_exp2f(st[e] - mn); ps += st[e]; }
    l = l * alpha + ps;
    o0 = o0 * alpha; o1 = o1 * alpha; o2 = o2 * alpha; o3 = o3 * alpha;
    u32x4 p0, p1;
    p0.x = cvtpk(st[0], st[1]); p0.y = cvtpk(st[2], st[3]); p0.z = cvtpk(st[4], st[5]); p0.w = cvtpk(st[6], st[7]);
    p1.x = cvtpk(st[8], st[9]); p1.y = cvtpk(st[10], st[11]); p1.z = cvtpk(st[12], st[13]); p1.w = cvtpk(st[14], st[15]);
    pf0 = __builtin_bit_cast(bf16x8, p0); pf1 = __builtin_bit_cast(bf16x8, p1);
}
DI void store_o(bf16_t* Oout, int ldo, int lane, float inv, const f32x16& o0, const f32x16& o1, const f32x16& o2, const f32x16& o3) {
    const int q = lane & 31, hi = lane >> 5;
    bf16_t* op = Oout + (size_t)q * ldo + 4 * hi;
#pragma unroll
    for (int gq = 0; gq < 4; ++gq) {
        *(u32x2*)(op + 0 + 8 * gq) = (u32x2){cvtpk(o0[4 * gq] * inv, o0[4 * gq + 1] * inv), cvtpk(o0[4 * gq + 2] * inv, o0[4 * gq + 3] * inv)};
        *(u32x2*)(op + 32 + 8 * gq) = (u32x2){cvtpk(o1[4 * gq] * inv, o1[4 * gq + 1] * inv), cvtpk(o1[4 * gq + 2] * inv, o1[4 * gq + 3] * inv)};
        *(u32x2*)(op + 64 + 8 * gq) = (u32x2){cvtpk(o2[4 * gq] * inv, o2[4 * gq + 1] * inv), cvtpk(o2[4 * gq + 2] * inv, o2[4 * gq + 3] * inv)};
        *(u32x2*)(op + 96 + 8 * gq) = (u32x2){cvtpk(o3[4 * gq] * inv, o3[4 * gq + 1] * inv), cvtpk(o3[4 * gq + 2] * inv, o3[4 * gq + 3] * inv)};
    }
}
constexpr int ATT_STG = 40960, ATT_KR = 16384, ATT_VT = 24576;
DI void attn_unit_prompt(int b, int h, int u, const Args& a, const Ctx& c) {
    unsigned char* ws = a.ws;
    const bf16_t* Q = (const bf16_t*)(ws + A_Q); const bf16_t* KN = (const bf16_t*)(ws + A_KN); const bf16_t* VT = (const bf16_t*)(ws + A_VT);
    const bf16_t* KR = (const bf16_t*)(ws + A_MISC) + 1024; bf16_t* MIX = (bf16_t*)(a.out + O_Y);
    const float* rc = (const float*)(ws + WS_ROPE); const float* rs = rc + 65536;
    const int lane = c.lane, w = c.wave, q = lane & 31, hi = lane >> 5;
    const int krow0 = b * 2048, row_q0 = krow0 + 256 * u + 32 * w;
    const int NT = 4 * u + 4, mylim = 4 * u + (w >> 1) + 1;
    LAS unsigned char* L = c.lds;
    const char* bKN = (const char*)(KN + (size_t)krow0 * 1024 + h * 128);
    const char* bKR = (const char*)(KR + (size_t)krow0 * 1280);
    const char* bVT = (const char*)(VT + (size_t)(h * 128) * TKS + krow0);
#define ATT_DMA(stage) do { LAS unsigned char* sb_ = L + (stage) * ATT_STG; int ln_ = lane; asm volatile("" : "+v"(ln_)); \
        const int r0_ = 4 * w + (ln_ >> 4), r1_ = r0_ + 32, j_ = ln_ & 15, r2_ = 8 * w + (ln_ >> 3), d1_ = r2_ + 64, j8_ = ln_ & 7; \
        __builtin_amdgcn_global_load_lds((const unsigned*)(bKN + (unsigned)(r0_ * 2048 + ((j_ ^ (r0_ & 15)) << 4))), (LAS unsigned*)(sb_ + w * 1024), 16, 0, 0); \
        __builtin_amdgcn_global_load_lds((const unsigned*)(bKN + (unsigned)(r1_ * 2048 + ((j_ ^ (r1_ & 15)) << 4))), (LAS unsigned*)(sb_ + (w + 8) * 1024), 16, 0, 0); \
        __builtin_amdgcn_global_load_lds((const unsigned*)(bKR + (unsigned)(r2_ * 2560 + ((j8_ ^ ((r2_ >> 1) & 7)) << 4))), (LAS unsigned*)(sb_ + ATT_KR + w * 1024), 16, 0, 0); \
        __builtin_amdgcn_global_load_lds((const unsigned*)(bVT + (unsigned)(r2_ * (TKS * 2) + ((j8_ ^ ((r2_ >> 1) & 7)) << 4))), (LAS unsigned*)(sb_ + ATT_VT + w * 1024), 16, 0, 0); \
        __builtin_amdgcn_global_load_lds((const unsigned*)(bVT + (unsigned)(d1_ * (TKS * 2) + ((j8_ ^ ((d1_ >> 1) & 7)) << 4))), (LAS unsigned*)(sb_ + ATT_VT + (w + 8) * 1024), 16, 0, 0); \
        bKN += 64 * 2048; bKR += 64 * 2560; bVT += 128; } while (0)
    ATT_DMA(0);
    if (NT > 1) ATT_DMA(1);
    bf16x8 qf[12];
    load_q_frags(qf, Q + (size_t)row_q0 * 1536 + h * 192, 1536, rc, rs, 256 * u + 32 * w, lane);
    f32x16 o0, o1, o2, o3;
#pragma unroll
    for (int e = 0; e < 16; ++e) { o0[e] = 0.f; o1[e] = 0.f; o2[e] = 0.f; o3[e] = 0.f; }
    float m = -1e30f, l = 0.f;
    const int pi = (q & ~12) | ((q & 4) << 1) | ((q & 8) >> 1);
    const unsigned kn_row = (unsigned)(pi * 256), kn_x0 = (unsigned)(((pi & 15) ^ hi) << 4);
    const unsigned kr_row = (unsigned)(ATT_KR + pi * 128), kr_x0 = (unsigned)((((pi >> 1) & 7) ^ hi) << 4);
    const unsigned vt_row = (unsigned)(ATT_VT + q * 128), vt_x0 = (unsigned)((((q >> 1) & 7) ^ hi) << 4);
    int stage = 0;
    for (int t = 0; t < NT; ++t) {
        if (t + 1 < NT) asm volatile("s_waitcnt vmcnt(5)" ::: "memory"); else asm volatile("s_waitcnt vmcnt(0)" ::: "memory");
        __builtin_amdgcn_s_barrier();
        asm volatile("" ::: "memory");
        if (t + 2 < NT) { const int s2 = stage >= 1 ? stage - 1 : 2; ATT_DMA(s2); }
        if (t < mylim) {
            const LAS unsigned char* S = L + stage * ATT_STG;
#pragma unroll
            for (int sub = 0; sub < 2; ++sub) {
                unsigned kn_x = kn_x0, kr_x = kr_x0, vt_x = vt_x0;
                asm volatile("" : "+v"(kn_x), "+v"(kr_x), "+v"(vt_x));
                const LAS unsigned char* kn = S + kn_row + sub * 32 * 256;
                const LAS unsigned char* kr = S + kr_row + sub * 32 * 128;
                f32x16 st;
#pragma unroll
                for (int e = 0; e < 16; ++e) st[e] = 0.f;
#pragma unroll
                for (int s = 0; s < 8; ++s) { const bf16x8 kf = *(const LAS bf16x8*)(kn + ((unsigned)(32 * s) ^ kn_x)); st = MFMA32(kf, qf[s], st); if ((s & 3) == 3) asm volatile("" ::: "memory"); }
#pragma unroll
                for (int s = 0; s < 4; ++s) { const bf16x8 kf = *(const LAS bf16x8*)(kr + ((unsigned)(32 * s) ^ kr_x)); st = MFMA32(kf, qf[8 + s], st); }
                asm volatile("" ::: "memory");
                bf16x8 pf0, pf1;
                softmax_step(st, m, l, o0, o1, o2, o3, pf0, pf1);
                asm volatile("" ::: "memory");
                const LAS unsigned char* vt = S + vt_row;
                const unsigned c0 = (unsigned)(64 * sub) ^ vt_x, c1 = (unsigned)(64 * sub + 32) ^ vt_x;
                { const bf16x8 v0 = *(const LAS bf16x8*)(vt + c0), v1 = *(const LAS bf16x8*)(vt + c1); o0 = MFMA32(v0, pf0, o0); o0 = MFMA32(v1, pf1, o0); }
                { const bf16x8 v0 = *(const LAS bf16x8*)(vt + 32 * 128 + c0), v1 = *(const LAS bf16x8*)(vt + 32 * 128 + c1); o1 = MFMA32(v0, pf0, o1); o1 = MFMA32(v1, pf1, o1); }
                { const bf16x8 v0 = *(const LAS bf16x8*)(vt + 64 * 128 + c0), v1 = *(const LAS bf16x8*)(vt + 64 * 128 + c1); o2 = MFMA32(v0, pf0, o2); o2 = MFMA32(v1, pf1, o2); }
                { const bf16x8 v0 = *(const LAS bf16x8*)(vt + 96 * 128 + c0), v1 = *(const LAS bf16x8*)(vt + 96 * 128 + c1); o3 = MFMA32(v0, pf0, o3); o3 = MFMA32(v1, pf1, o3); }
                asm volatile("" ::: "memory");
            }
        }
        stage = stage == 2 ? 0 : stage + 1;
    }
    l += __shfl_xor(l, 32);
    store_o(MIX + (size_t)row_q0 * 2048 + 1024 + h * 128, 2048, lane, 1.0f / l, o0, o1, o2, o3);
    asm volatile("s_waitcnt lgkmcnt(0)" ::: "memory");
    __builtin_amdgcn_s_barrier();
    asm volatile("" ::: "memory");
#undef ATT_DMA
}
DI void attn_prompt(const Args& a, const Ctx& c) {
    for (int p = blockIdx.x; p < 256; p += c.G) {
        const int b = p >> 5, h = (p >> 2) & 7, uu = p & 3;
#pragma unroll 1
        for (int k = 0; k < 2; ++k) attn_unit_prompt(b, h, k == 0 ? 7 - uu : uu, a, c);
    }
}
DI void attn_sample(const Args& a, const Ctx& c) {
    unsigned char* ws = a.ws;
    const bf16_t* Q = (const bf16_t*)(ws + A_Q); const bf16_t* KN = (const bf16_t*)(ws + A_KN); const bf16_t* VT = (const bf16_t*)(ws + A_VT);
    const bf16_t* KR = (const bf16_t*)(ws + WS_KRS); bf16_t* MIX = (bf16_t*)(a.out + O_Y);
    const float* rc = (const float*)(ws + WS_ROPE); const float* rs = rc + 65536;
    const int lane = c.lane, w = c.wave, q = lane & 31, hi = lane >> 5;
    LAS float* part = (LAS float*)c.lds;
    LAS float* ml = (LAS float*)(c.lds + 131072 + 1024);
    for (int it = blockIdx.x; it < 128; it += c.G) {
        const int b = it >> 3, h = it & 7;
        const int row_q0 = TP + 32 * b, krow0 = b * 1056;
        bf16x8 qf[12];
        load_q_frags(qf, Q + (size_t)row_q0 * 1536 + h * 192, 1536, rc, rs, 1024, lane);
        f32x16 o0, o1, o2, o3;
#pragma unroll
        for (int e = 0; e < 16; ++e) { o0[e] = 0.f; o1[e] = 0.f; o2[e] = 0.f; o3[e] = 0.f; }
        float m = -1e30f, l = 0.f;
        const int kt0 = (33 * w) >> 3, kt1 = (33 * (w + 1)) >> 3;
        const int pi = (q & ~12) | ((q & 4) << 1) | ((q & 8) >> 1);
        const bf16_t* kp = KN + (size_t)(krow0 + 32 * kt0 + pi) * 1024 + h * 128 + 8 * hi;
        const bf16_t* krp = KR + (size_t)(krow0 + 32 * kt0 + pi) * 64 + 8 * hi;
        const bf16_t* vp = VT + (size_t)(h * 128 + q) * TKS + krow0 + 32 * kt0 + 8 * hi;
        for (int kt = kt0; kt < kt1; ++kt) {
            bf16x8 kf[12];
#pragma unroll
            for (int s = 0; s < 8; ++s) kf[s] = *(const bf16x8*)(kp + 16 * s);
#pragma unroll
            for (int s = 0; s < 4; ++s) kf[8 + s] = *(const bf16x8*)(krp + 16 * s);
            bf16x8 vf[4][2];
#pragma unroll
            for (int blk = 0; blk < 4; ++blk) { vf[blk][0] = *(const bf16x8*)(vp + (size_t)(32 * blk) * TKS); vf[blk][1] = *(const bf16x8*)(vp + (size_t)(32 * blk) * TKS + 16); }
            f32x16 st;
#pragma unroll
            for (int e = 0; e < 16; ++e) st[e] = 0.f;
#pragma unroll
            for (int s = 0; s < 12; ++s) st = MFMA32(kf[s], qf[s], st);
            bf16x8 pf0, pf1;
            softmax_step(st, m, l, o0, o1, o2, o3, pf0, pf1);
            o0 = MFMA32(vf[0][0], pf0, o0); o0 = MFMA32(vf[0][1], pf1, o0);
            o1 = MFMA32(vf[1][0], pf0, o1); o1 = MFMA32(vf[1][1], pf1, o1);
            o2 = MFMA32(vf[2][0], pf0, o2); o2 = MFMA32(vf[2][1], pf1, o2);
            o3 = MFMA32(vf[3][0], pf0, o3); o3 = MFMA32(vf[3][1], pf1, o3);
            kp += 32 * 1024; krp += 32 * 64; vp += 32;
        }
        l += __shfl_xor(l, 32);
#pragma unroll
        for (int e = 0; e < 16; ++e) {
            part[(w * 64 + e) * 64 + lane] = o0[e]; part[(w * 64 + 16 + e) * 64 + lane] = o1[e];
            part[(w * 64 + 32 + e) * 64 + lane] = o2[e]; part[(w * 64 + 48 + e) * 64 + lane] = o3[e];
        }
        ml[(w * 2) * 64 + lane] = m; ml[(w * 2 + 1) * 64 + lane] = l;
        __syncthreads();
        float M = -1e30f;
#pragma unroll
        for (int ww = 0; ww < 8; ++ww) M = fmaxf(M, ml[(ww * 2) * 64 + lane]);
        float sc[8]; float Lt = 0.f;
#pragma unroll
        for (int ww = 0; ww < 8; ++ww) { sc[ww] = __builtin_amdgcn_exp2f(ml[(ww * 2) * 64 + lane] - M); Lt += ml[(ww * 2 + 1) * 64 + lane] * sc[ww]; }
        const float inv = 1.0f / Lt;
        float ov[8];
#pragma unroll
        for (int j = 0; j < 8; ++j) {
            float acc = 0.f;
#pragma unroll
            for (int ww = 0; ww < 8; ++ww) acc += part[(ww * 64 + 8 * w + j) * 64 + lane] * sc[ww];
            ov[j] = acc * inv;
        }
        {
            const int blk = w >> 1, gq0 = 2 * (w & 1);
            bf16_t* op = MIX + (size_t)(row_q0 + q) * 2048 + 1024 + h * 128 + 32 * blk + 4 * hi;
            *(u32x2*)(op + 8 * gq0) = (u32x2){cvtpk(ov[0], ov[1]), cvtpk(ov[2], ov[3])};
            *(u32x2*)(op + 8 * (gq0 + 1)) = (u32x2){cvtpk(ov[4], ov[5]), cvtpk(ov[6], ov[7])};
        }
        __syncthreads();
    }
}
DI void assemble_sample_keys(const Args& a, const Ctx& c) {
    unsigned char* ws = a.ws;
    const bf16_t* MISC = (const bf16_t*)(ws + A_MISC); bf16_t* LATS = (bf16_t*)(ws + WS_LATS); bf16_t* KRS = (bf16_t*)(ws + WS_KRS);
    const float* cl = a.in[2]; const float* ck = a.in[3];
    for (int r0 = c.gw; r0 < TKS; r0 += 4 * c.ngw) {
        u32x4 lw[4], kw[4];
#pragma unroll
        for (int k = 0; k < 4; ++k) {
            const int r = r0 + k * c.ngw;
            if (r < TKS) {
                const int b = r / 1056, j = r - b * 1056;
                if (j < 1024) {
                    const float* src = cl + ((size_t)b * 1024 + j) * 512 + 8 * c.lane;
                    const f32x4 v0 = *(const f32x4*)src, v1 = *(const f32x4*)(src + 4);
                    lw[k].x = cvtpk(v0[0], v0[1]); lw[k].y = cvtpk(v0[2], v0[3]); lw[k].z = cvtpk(v1[0], v1[1]); lw[k].w = cvtpk(v1[2], v1[3]);
                    if (c.lane < 8) { const float* s2 = ck + ((size_t)b * 1024 + j) * 64 + 8 * c.lane; const f32x4 k0 = *(const f32x4*)s2, k1 = *(const f32x4*)(s2 + 4);
                        kw[k].x = cvtpk(k0[0], k0[1]); kw[k].y = cvtpk(k0[2], k0[3]); kw[k].z = cvtpk(k1[0], k1[1]); kw[k].w = cvtpk(k1[2], k1[3]); }
                } else {
                    const bf16_t* mrow = MISC + (size_t)(TP + b * 32 + (j - 1024)) * 1280;
                    lw[k] = *(const u32x4*)(mrow + 512 + 8 * c.lane);
                    if (c.lane < 8) kw[k] = *(const u32x4*)(mrow + 1024 + 8 * c.lane);
                }
            }
        }
#pragma unroll
        for (int k = 0; k < 4; ++k) {
            const int r = r0 + k * c.ngw;
            if (r < TKS) { *(u32x4*)(LATS + (size_t)r * 512 + 8 * c.lane) = lw[k]; if (c.lane < 8) *(u32x4*)(KRS + (size_t)r * 64 + 8 * c.lane) = kw[k]; }
        }
    }
}

DI void run_store_gemm(int gi, const Args& a, const Ctx& c) {
    unsigned char* ws = a.ws;
    pg8::Gemm g; pg8::EpiStore E; E.t1 = 1 << 30; E.t2 = 1 << 30; E.O1 = nullptr; E.ld1 = 0; E.O2 = nullptr; E.ld2 = 0;
    switch (gi) {
        case 0:
            g = pg8::Gemm{(const bf16_t*)(ws + WS_HB), (const bf16_t*)(ws + WS_WIN), DM, DM, T, NIN, DM, nullptr, nullptr};
            E.O0 = (bf16_t*)(ws + A_Z); E.ld0 = 1024; E.t1 = 4; E.O1 = (bf16_t*)(ws + A_XBC); E.ld1 = 1536; E.t2 = 10; E.O2 = (bf16_t*)(ws + A_MISC); E.ld2 = 1280; break;
        case 1:
            g = pg8::Gemm{(const bf16_t*)(ws + A_MISC), (const bf16_t*)(ws + WS_WUQ), 1280, 512, T, 1536, 512, nullptr, nullptr};
            E.O0 = (bf16_t*)(ws + A_Q); E.ld0 = 1536; break;
        case 2:
            g = pg8::Gemm{(const bf16_t*)(ws + A_MISC) + 512, (const bf16_t*)(ws + WS_WUK), 1280, 512, TP, 1024, 512, nullptr, nullptr};
            E.O0 = (bf16_t*)(ws + A_KN); E.ld0 = 1024; break;
        case 3:
            g = pg8::Gemm{(const bf16_t*)(ws + WS_WUV), (const bf16_t*)(ws + A_MISC) + 512, 512, 1280, 1024, TP, 512, nullptr, nullptr};
            E.O0 = (bf16_t*)(ws + A_VT); E.ld0 = TKS; break;
        case 4:
            g = pg8::Gemm{(const bf16_t*)(ws + WS_LATS), (const bf16_t*)(ws + WS_WUK), 512, 512, TKS, 1024, 512, nullptr, nullptr};
            E.O0 = (bf16_t*)(ws + A_KN); E.ld0 = 1024; break;
        default:
            g = pg8::Gemm{(const bf16_t*)(ws + WS_WUV), (const bf16_t*)(ws + WS_LATS), 512, 512, 1024, TKS, 512, nullptr, nullptr};
            E.O0 = (bf16_t*)(ws + A_VT); E.ld0 = TKS; break;
    }
    pg8::StaticOrder S; S.init(g.M, g.N, g.K, c.G, (int)blockIdx.x);
    pg8::gemm_phase<pg8::EpiStore, pg8::StaticOrder>(c.lds, g, S, E);
}
DI void run_swiglu_gemm(int which, const Args& a, const Ctx& c) {
    unsigned char* ws = a.ws;
    pg8::Gemm g{(const bf16_t*)(ws + WS_HB), (const bf16_t*)(ws + (which == 0 ? WS_WGU1 : WS_WGU2)), DM, DM, T, 2 * DFF, DM, nullptr, nullptr};
    pg8::EpiSwiGLU E{(bf16_t*)(ws + (which == 0 ? A_ACT : A_ACT2)), DFF};
    pg8::StaticOrder S; S.init(g.M, g.N, g.K, c.G, (int)blockIdx.x);
    pg8::gemm_phase<pg8::EpiSwiGLU, pg8::StaticOrder>(c.lds, g, S, E);
}
DI void run_res_gemm(int which, const Args& a, const Ctx& c) {
    unsigned char* ws = a.ws;
    pg8::Gemm g; pg8::EpiRes<false> E; E.xp = nullptr; E.xs = nullptr; E.hb = (const bf16_t*)(ws + WS_HB); E.alpha = ALPHA;
    int S_;
    if (which == 1) { g = pg8::Gemm{(const bf16_t*)(a.out + O_Y), (const bf16_t*)(ws + WS_WOUT), 2048, 2048, T, DM, 2048, nullptr, nullptr}; E.out = (float*)(ws + A_R2); E.s = 1.0f; E.part = (float*)(ws + A_PART); S_ = 8; }
    else { g = pg8::Gemm{(const bf16_t*)(ws + A_ACT2), (const bf16_t*)(ws + WS_WD2), DFF, DFF, T, DM, DFF, nullptr, nullptr}; E.out = a.out + O_Y; E.s = 0.5f; E.part = (float*)(ws + A_PART2); S_ = 11; }
    pg8::SplitOrder S; S.init(g.K, S_, c.G, (int)blockIdx.x);
    pg8::gemm_phase<pg8::EpiRes<false>, pg8::SplitOrder>(c.lds, g, S, E);
}

#define XB_TMO      128
#define XB_XCNT(j)  (256  + 64 * (j))
#define XB_XSUB(j)  (1280 + 64 * (j))
#define XB_XGEN(j)  (2304 + 64 * (j))
#define XB_TOP      3328
#define XB_TOPGEN   3392
#define XCD_BAR_WORDS 3456
#define XB_SPIN_CAP (1u << 18)
DI unsigned xb_ld(unsigned* p)              { return __hip_atomic_load(p, __ATOMIC_RELAXED, __HIP_MEMORY_SCOPE_AGENT); }
DI unsigned xb_add(unsigned* p, unsigned v) { return __hip_atomic_fetch_add(p, v, __ATOMIC_RELAXED, __HIP_MEMORY_SCOPE_AGENT); }
DI unsigned xb_xcc_id() { return (unsigned)__builtin_amdgcn_s_getreg((3 << 11) | 20) & 0xFu; }
#define XB_SPIN(cond, bar) do { unsigned _sp = 0; while (cond) { __builtin_amdgcn_s_sleep(1); \
    if ((++_sp & 255u) == 0u) { if (xb_ld(&(bar)[XB_TMO])) break; if (_sp > XB_SPIN_CAP) { atomicAdd(&(bar)[XB_TMO], 1u); break; } } } } while (0)
struct XcdBarrier { unsigned* bar; unsigned x; volatile LAS unsigned* st; };
DI XcdBarrier xcd_barrier_post(unsigned* bar, volatile LAS unsigned* st) {
    XcdBarrier b; b.bar = bar; b.x = xb_xcc_id(); b.st = st;
    if (threadIdx.x == 0) (void)xb_add(&bar[XB_XCNT(b.x)], 1u);
    return b;
}
DI void xcd_barrier_complete(unsigned* bar, unsigned x, unsigned& nloc, unsigned& nx) {
    const unsigned G = gridDim.x * gridDim.y * gridDim.z;
    unsigned sum, cnt, mine, sp = 0u;
    for (;;) {
        sum = 0u; cnt = 0u; mine = 0u;
#pragma unroll
        for (unsigned j = 0; j < 16; ++j) { const unsigned c = xb_ld(&bar[XB_XCNT(j)]); sum += c; cnt += (c > 0u) ? 1u : 0u; mine = (j == x) ? c : mine; }
        if (sum == G) break;
        __builtin_amdgcn_s_sleep(1);
        if ((++sp & 255u) == 0u) { if (xb_ld(&bar[XB_TMO])) break; if (sp > XB_SPIN_CAP) { atomicAdd(&bar[XB_TMO], 1u); break; } }
    }
    nloc = mine > 0u ? mine : 1u; nx = cnt > 0u ? cnt : 1u;
}
DI void xcd_barrier(const XcdBarrier& b) {
    asm volatile("s_waitcnt vmcnt(0)" ::: "memory");
    __syncthreads();
    if (threadIdx.x == 0) {
        unsigned* bar = b.bar;
        __builtin_amdgcn_s_waitcnt(0);
        unsigned nloc = b.st[0], nx = b.st[1];
        if (nloc == 0u) { xcd_barrier_complete(bar, b.x, nloc, nx); b.st[0] = nloc; b.st[1] = nx; }
        const unsigned old = xb_add(&bar[XB_XSUB(b.x)], 1u);
        const unsigned gen = old / nloc;
        if (old + 1u == (gen + 1u) * nloc) {
            __builtin_amdgcn_fence(__ATOMIC_RELEASE, "agent");
            asm volatile("s_waitcnt vmcnt(0)" ::: "memory");
            const unsigned og = xb_add(&bar[XB_TOP], 1u);
            const unsigned tg = og / nx;
            if (og + 1u == (tg + 1u) * nx) xb_add(&bar[XB_TOPGEN], 1u);
            else XB_SPIN(xb_ld(&bar[XB_TOPGEN]) == tg, bar);
            __builtin_amdgcn_fence(__ATOMIC_ACQUIRE, "agent");
            xb_add(&bar[XB_XGEN(b.x)], 1u);
            asm volatile("s_waitcnt vmcnt(0)" ::: "memory");
        } else {
            XB_SPIN(xb_ld(&bar[XB_XGEN(b.x)]) == gen, bar);
            __builtin_amdgcn_fence(__ATOMIC_ACQUIRE, "agent");
            asm volatile("s_waitcnt vmcnt(0)" ::: "memory");
        }
    }
    __syncthreads();
}

constexpr int NPHASE = 18;
__global__ void __launch_bounds__(512, 2) fwd_kernel(Args a) {
    extern __shared__ __attribute__((aligned(16))) unsigned char lds_raw[];
    Ctx c;
    c.lds = (LAS unsigned char*)lds_raw;
    c.tid = threadIdx.x; c.lane = c.tid & 63; c.wave = __builtin_amdgcn_readfirstlane(c.tid >> 6);
    c.G = gridDim.x; c.gw = blockIdx.x * 8 + c.wave; c.ngw = c.G * 8;
    unsigned char* ws = a.ws;
    volatile LAS unsigned* lctl = (volatile LAS unsigned*)(c.lds + 131072 + 512);
    if (c.tid < 64) lctl[c.tid] = 0u;
    __syncthreads();
    XcdBarrier bar; bar.bar = (unsigned*)ws; bar.x = 0; bar.st = lctl + 8;
    if (a.coop) bar = xcd_barrier_post((unsigned*)ws, lctl + 8);
    const int wave_s = c.wave;
    const int lo = a.ph_lo, hi = a.ph_hi;
#define IN(k) (lo <= (k) && (k) < hi)
#define FRESH() do { int l_ = (int)__builtin_amdgcn_mbcnt_hi(~0u, __builtin_amdgcn_mbcnt_lo(~0u, 0u)); asm volatile("" : "+v"(l_)); c.lane = l_; c.wave = wave_s; c.tid = wave_s * 64 + l_; c.gw = blockIdx.x * 8 + wave_s; } while (0)
#define SEAM(k) do { if ((k) + 1 < hi) { if (a.coop) { if (a.pad == 0x7fffffff) cg::this_grid().sync(); xcd_barrier(bar); } else __syncthreads(); } } while (0)
    if (IN(0)) { FRESH(); p0_prologue(a, c); SEAM(0); }
    if (IN(1)) { FRESH(); run_swiglu_gemm(0, a, c); SEAM(1); }
    if (IN(2)) { FRESH();
        pg8::Gemm g{(const bf16_t*)(ws + A_ACT), (const bf16_t*)(ws + WS_WD1), DFF, DFF, T, DM, DFF, nullptr, nullptr};
        pg8::EpiRes<true> E{a.out + O_Y, a.in[0], a.in[1], nullptr, ALPHA, 0.5f, (float*)(ws + A_PART)};
        pg8::SplitOrder S; S.init(g.K, 11, c.G, (int)blockIdx.x);
        pg8::gemm_phase<pg8::EpiRes<true>, pg8::SplitOrder>(c.lds, g, S, E);
        SEAM(2);
    }
    if (IN(3)) { FRESH(); ln_pass(a.out + O_Y, a.in[6], a.in[7], (bf16_t*)(ws + WS_HB), nullptr, c, (const float*)(ws + A_PART), 11, a.in[1], nullptr, 0.5f); SEAM(3); }
    if (IN(4)) { FRESH(); run_store_gemm(0, a, c); SEAM(4); }
    if (IN(5)) { FRESH(); post_proj(a, c); SEAM(5); }
    if (IN(6)) { FRESH(); ssd_a(a, c); SEAM(6); }
    if (IN(7)) { FRESH(); ssd_scan(a, c); SEAM(7); }
    if (IN(8)) { FRESH(); ssd_c(a, c); SEAM(8); }
    if (IN(9)) { FRESH(); for (int gi = 1; gi <= 3; ++gi) run_store_gemm(gi, a, c); assemble_sample_keys(a, c); SEAM(9); }
    if (IN(10)) { FRESH(); attn_prompt(a, c); SEAM(10); }
    if (IN(11)) { FRESH(); {
            pg8::Gemm g{(const bf16_t*)(ws + WS_LATS), (const bf16_t*)(ws + WS_WUK), 512, 512, TKS, 1024, 512, (const bf16_t*)(ws + WS_WUV), (const bf16_t*)(ws + WS_LATS)};
            pg8::EpiStore E; E.O0 = (bf16_t*)(ws + A_KN); E.ld0 = 1024; E.t1 = 1 << 30; E.t2 = 1 << 30; E.O1 = (bf16_t*)(ws + A_VT); E.ld1 = TKS; E.O2 = nullptr; E.ld2 = 0;
            pg8::DualOrder S; S.init((TKS / 256) * 4, 4 * (TKS / 256), 512, c.G, (int)blockIdx.x);
            pg8::gemm_phase<pg8::EpiStore, pg8::DualOrder>(c.lds, g, S, E);
        }
        SEAM(11); }
    if (IN(12)) { FRESH(); attn_sample(a, c); SEAM(12); }
    if (IN(13)) { FRESH(); run_res_gemm(1, a, c); SEAM(13); }
    if (IN(14)) { FRESH(); ln_pass((const float*)(ws + A_R2), a.in[23], a.in[24], (bf16_t*)(ws + WS_HB), nullptr, c, (const float*)(ws + A_PART), 8, nullptr, (const bf16_t*)(ws + WS_HB), 1.0f); SEAM(14); }
    if (IN(15)) { FRESH(); run_swiglu_gemm(1, a, c); SEAM(15); }
    if (IN(16)) { FRESH(); run_res_gemm(2, a, c); SEAM(16); }
    if (IN(17)) { FRESH(); ln_pass(a.out + O_Y, a.in[28], a.in[29], nullptr, a.out + O_Y, c, (const float*)(ws + A_PART2), 11, nullptr, (const bf16_t*)(ws + WS_HB), 0.5f); }
#undef IN
#undef SEAM
#undef FRESH
}

#ifndef N_LAUNCH_MODE
#define N_LAUNCH_MODE 0
#endif
extern "C" void kernel_launch(void* const* d_in, const int* in_sizes, int n_in, void* d_out, int out_size, void* d_ws, size_t ws_size, hipStream_t stream) {
    static int grid = 0;
    if (grid == 0) {
        int dev = 0, cus = 0, per_cu = 0;
        if (hipGetDevice(&dev) != hipSuccess || hipDeviceGetAttribute(&cus, hipDeviceAttributeMultiprocessorCount, dev) != hipSuccess) { fprintf(stderr, "kernel_launch: device query failed\n"); grid = -1; return; }
        if (hipFuncSetAttribute((const void*)fwd_kernel, hipFuncAttributeMaxDynamicSharedMemorySize, LDS_BYTES) != hipSuccess) { fprintf(stderr, "kernel_launch: hipFuncSetAttribute failed\n"); grid = -1; return; }
        if (hipOccupancyMaxActiveBlocksPerMultiprocessor(&per_cu, (const void*)fwd_kernel, 512, LDS_BYTES) != hipSuccess || per_cu < 1) { fprintf(stderr, "kernel_launch: occupancy query says %d\n", per_cu); per_cu = 1; }
        (void)hipGetLastError();
        grid = cus;
        if (n_in != 30 || ws_size < 256 * MiB) fprintf(stderr, "kernel_launch: unexpected n_in %d / ws %zu\n", n_in, ws_size);
    }
    if (grid < 0) return;
    Args a{};
    for (int i = 0; i < 30; ++i) a.in[i] = (const float*)d_in[i];
    a.out = (float*)d_out; a.ws = (unsigned char*)d_ws;
    for (int i = 0; i < 32; ++i) a.inv_freq[i] = powf(10000.0f, -(float)(2 * i) / 64.0f);
    a.pad = 0;
    if (hipMemsetAsync(d_ws, 0, 65536, stream) != hipSuccess) { fprintf(stderr, "kernel_launch: memset failed\n"); return; }
#if N_LAUNCH_MODE == 0
    a.ph_lo = 0; a.ph_hi = NPHASE; a.coop = 1;
    void* params[] = {&a};
    hipError_t e = hipLaunchCooperativeKernel((const void*)fwd_kernel, dim3(grid), dim3(512), params, LDS_BYTES, stream);
    if (e != hipSuccess) fprintf(stderr, "kernel_launch: cooperative launch failed: %s (grid %d)\n", hipGetErrorString(e), grid);
#else
    for (int ph = 0; ph < NPHASE; ++ph) {
        a.ph_lo = ph; a.ph_hi = ph + 1; a.coop = 0;
        hipLaunchKernelGGL(fwd_kernel, dim3(grid), dim3(512), LDS_BYTES, stream, a);
    }
#endif
}
```
